# Optimizing an MI355X kernel written in HIP

```python
import math
import jax, jax.numpy as jnp
from jax import lax
import numpy as np

D_MODEL = 2048
BATCH = 1
SEQ = 8192
DEPTH = 1

ATT_HEAD_DIM = 128
ATT_HEADS_PER_GROUP = 8
DILATION_GROUPS = ((128, 1), (512, 4), (2048, 16))
N_ATT_GROUPS = len(DILATION_GROUPS)
ATT_GROUP_WIDTH = ATT_HEADS_PER_GROUP * ATT_HEAD_DIM
ROPE_DIM = ATT_HEAD_DIM // 4
ROPE_THETA = 500000.0
ATT_BLOCK = 128

RET_HEADS = 8
RET_QK_DIM = D_MODEL // 16
RET_V_DIM = 2 * RET_QK_DIM
RET_CHUNK = 128
RET_ROT_BASE = 10000.0

N_EXPERT_GROUPS = 4
EXPERTS_PER_GROUP = 8
N_EXPERTS = N_EXPERT_GROUPS * EXPERTS_PER_GROUP
TOP_K = 2
EXPERT_HIDDEN = D_MODEL // 4
MOE_BLOCK = 128

ALPHA = (2.0 * DEPTH) ** 0.25
BETA = (8.0 * DEPTH) ** -0.25
LN_EPS = 1e-5
NEG_INF = -1e30

IN_SPLITS = (N_ATT_GROUPS * ATT_GROUP_WIDTH,) * 3 + (RET_HEADS * RET_QK_DIM,) * 2 + (RET_HEADS * RET_V_DIM,) * 2 + (D_MODEL,) * 2
IN_WIDTH = sum(IN_SPLITS)

kernel_name = "hybrid_dilated_attn_retention_hmoe_deepnorm"


def layer_norm(x, scale, bias):
    xf = x.astype(jnp.float32)
    mu = jnp.mean(xf, axis=-1, keepdims=True)
    var = jnp.mean(jnp.square(xf - mu), axis=-1, keepdims=True)
    y = (xf - mu) * lax.rsqrt(var + LN_EPS) * scale.astype(jnp.float32) + bias.astype(jnp.float32)
    return y.astype(x.dtype)


def rotary(x, positions, inv_freq):
    rot = 2 * inv_freq.shape[0]
    ang = positions.astype(jnp.float32)[:, :, None, None] * inv_freq
    cos, sin = jnp.cos(ang), jnp.sin(ang)
    xr = x[..., :rot].astype(jnp.float32)
    x1, x2 = xr[..., : rot // 2], xr[..., rot // 2:]
    rotated = jnp.concatenate([x1 * cos - x2 * sin, x2 * cos + x1 * sin], axis=-1).astype(x.dtype)
    return jnp.concatenate([rotated, x[..., rot:]], axis=-1)


def dilated_window_attention(q, k, v, dilation, steps):
    B, S, H, Dh = q.shape
    M = -(-S // (dilation * ATT_BLOCK)) * ATT_BLOCK
    pad = M * dilation - S
    nb = M // ATT_BLOCK

    def to_blocks(t):
        t = jnp.pad(t, ((0, 0), (0, pad), (0, 0), (0, 0)))
        t = t.reshape(B, M, dilation, H, Dh).transpose(0, 2, 1, 3, 4)
        return t.reshape(B * dilation, nb, ATT_BLOCK, H, Dh)

    def with_prev(t):
        prev = jnp.pad(t[:, :-1], ((0, 0), (1, 0), (0, 0), (0, 0), (0, 0)))
        return jnp.concatenate([prev, t], axis=2)

    qb = to_blocks(q)
    kw = with_prev(to_blocks(k))
    vw = with_prev(to_blocks(v))
    s = jnp.einsum('bnqhd,bnkhd->bnhqk', qb, kw, preferred_element_type=jnp.float32) * (Dh ** -0.5)
    i = jnp.arange(ATT_BLOCK)[:, None]
    j = jnp.arange(2 * ATT_BLOCK)[None, :]
    dist = i + ATT_BLOCK - j
    band = (dist >= 0) & (dist <= steps)
    has_prev = (jnp.arange(nb) > 0)[:, None, None] | (j >= ATT_BLOCK)[None]
    mask = band[None] & has_prev
    s = jnp.where(mask[None, :, None], s, NEG_INF)
    lse = jax.nn.logsumexp(s, axis=-1)
    p = jnp.exp(s - lse[..., None])
    o = jnp.einsum('bnhqk,bnkhd->bnqhd', p.astype(v.dtype), vw)
    o = o.reshape(B, dilation, M, H, Dh).transpose(0, 2, 1, 3, 4).reshape(B, M * dilation, H, Dh)[:, :S]
    lse = lse.transpose(0, 1, 3, 2).reshape(B, dilation, M, H).transpose(0, 2, 1, 3).reshape(B, M * dilation, H)[:, :S]
    return o, lse


def retention_chunkwise(q, k, v, log_decay):
    B, S, H, dk = q.shape
    dv = v.shape[-1]
    nc = S // RET_CHUNK
    qc = q.reshape(B, nc, RET_CHUNK, H, dk)
    kc = k.reshape(B, nc, RET_CHUNK, H, dk)
    vc = v.reshape(B, nc, RET_CHUNK, H, dv)
    n = jnp.arange(RET_CHUNK, dtype=jnp.float32)
    diff = n[:, None] - n[None, :]
    intra = jnp.where(diff >= 0, jnp.exp(jnp.maximum(diff, 0.0) * log_decay[:, None, None]), 0.0)
    scores = jnp.einsum('bcnhd,bcmhd->bchnm', qc, kc) * intra
    inner = jnp.einsum('bchnm,bcmhe->bcnhe', scores, vc)
    k_decay = jnp.exp((RET_CHUNK - 1 - n)[None, :] * log_decay[:, None])
    kv = jnp.einsum('bcmhd,hm,bcmhe->bchde', kc, k_decay, vc)
    chunk_decay = jnp.exp(RET_CHUNK * log_decay)[None, :, None, None]

    def step(state, kv_c):
        return chunk_decay * state + kv_c, state

    _, prev_states = lax.scan(step, jnp.zeros((B, H, dk, dv), jnp.float32), kv.transpose(1, 0, 2, 3, 4))
    q_decay = jnp.exp((n + 1.0)[None, :] * log_decay[:, None])
    cross = jnp.einsum('bcnhd,hn,cbhde->bcnhe', qc, q_decay, prev_states)
    return (inner + cross).reshape(B, S, H, dv)


def mixer_sublayer(h, positions, w_in, w_branch_attn, w_branch_ret, w_out):
    B, S, _ = h.shape
    proj = jnp.einsum('bsd,df->bsf', h, w_in)
    split_points = list(np.cumsum(IN_SPLITS)[:-1])
    q_a, k_a, v_a, q_r, k_r, v_r, g_r, gate_a, gate_b = jnp.split(proj, split_points, axis=-1)

    att_shape = (B, S, N_ATT_GROUPS * ATT_HEADS_PER_GROUP, ATT_HEAD_DIM)
    inv_a = ROPE_THETA ** (-jnp.arange(0, ROPE_DIM, 2, dtype=jnp.float32) / ROPE_DIM)
    grp_shape = (B, S, N_ATT_GROUPS, ATT_HEADS_PER_GROUP, ATT_HEAD_DIM)
    q_a = rotary(q_a.reshape(att_shape), positions, inv_a).reshape(grp_shape)
    k_a = rotary(k_a.reshape(att_shape), positions, inv_a).reshape(grp_shape)
    v_a = v_a.reshape(grp_shape)
    outs, lses = [], []
    for g, (window, dilation) in enumerate(DILATION_GROUPS):
        o_g, lse_g = dilated_window_attention(q_a[:, :, g], k_a[:, :, g], v_a[:, :, g], dilation, window // dilation)
        outs.append(o_g.astype(jnp.float32))
        lses.append(lse_g)
    mix_w = jax.nn.softmax(jnp.stack(lses, axis=0), axis=0)
    o_a = jnp.einsum('gbsh,gbshd->bshd', mix_w, jnp.stack(outs, axis=0))
    o_a = o_a.reshape(B, S, ATT_GROUP_WIDTH).astype(h.dtype)

    inv_r = RET_ROT_BASE ** (-jnp.linspace(0.0, 1.0, RET_QK_DIM // 2, dtype=jnp.float32))
    q_r = rotary(q_r.reshape(B, S, RET_HEADS, RET_QK_DIM), positions, inv_r).astype(jnp.float32)
    k_r = rotary(k_r.reshape(B, S, RET_HEADS, RET_QK_DIM), positions, inv_r).astype(jnp.float32) * (RET_QK_DIM ** -0.5)
    v_r = v_r.reshape(B, S, RET_HEADS, RET_V_DIM).astype(jnp.float32)
    log_decay = jnp.log1p(-jnp.exp2(-5.0 - jnp.arange(RET_HEADS, dtype=jnp.float32)))
    o_r = retention_chunkwise(q_r, k_r, v_r, log_decay)
    mu = jnp.mean(o_r, axis=-1, keepdims=True)
    var = jnp.mean(jnp.square(o_r - mu), axis=-1, keepdims=True)
    o_r = ((o_r - mu) * lax.rsqrt(var + LN_EPS)).reshape(B, S, RET_HEADS * RET_V_DIM)
    o_r = (jax.nn.silu(g_r.astype(jnp.float32)) * o_r).astype(h.dtype)

    y_a = jnp.einsum('bsf,fd->bsd', o_a, w_branch_attn)
    y_r = jnp.einsum('bsf,fd->bsd', o_r, w_branch_ret)
    merged = jax.nn.sigmoid(gate_a) * y_a + jax.nn.sigmoid(gate_b) * y_r
    return jnp.einsum('bsd,de->bse', merged, w_out)


def hierarchical_moe(h, w_group_router, b_group_router, w_expert_router, b_expert_router, w_gate, w_up, w_down):
    B, S, D = h.shape
    T = B * S
    xt = h.reshape(T, D)
    xf = xt.astype(jnp.float32)
    g_logits = xf @ w_group_router.astype(jnp.float32) + b_group_router.astype(jnp.float32)
    g_prob = jax.nn.softmax(g_logits, axis=-1)
    g_sel = jnp.argmax(g_logits, axis=-1)
    p_group = jnp.take_along_axis(g_prob, g_sel[:, None], axis=1)[:, 0]
    e_logits = jnp.einsum('td,gde->tge', xf, w_expert_router.astype(jnp.float32)) + b_expert_router.astype(jnp.float32)
    idx = jnp.broadcast_to(g_sel[:, None, None], (T, 1, EXPERTS_PER_GROUP))
    e_logits = jnp.take_along_axis(e_logits, idx, axis=1)[:, 0]
    top_vals, top_idx = lax.top_k(e_logits, TOP_K)
    weights = p_group[:, None] * jax.nn.softmax(top_vals, axis=-1)
    expert_id = g_sel[:, None].astype(jnp.int32) * EXPERTS_PER_GROUP + top_idx.astype(jnp.int32)

    A = T * TOP_K
    e_flat = expert_id.reshape(A)
    t_flat = jnp.repeat(jnp.arange(T, dtype=jnp.int32), TOP_K)
    w_flat = weights.reshape(A)
    order = jnp.argsort(e_flat)
    e_s, t_s, w_s = e_flat[order], t_flat[order], w_flat[order]
    counts = jnp.zeros((N_EXPERTS,), jnp.int32).at[e_flat].add(1)
    starts = jnp.cumsum(counts) - counts
    pcounts = (counts + MOE_BLOCK - 1) // MOE_BLOCK * MOE_BLOCK
    pends = jnp.cumsum(pcounts)
    pstarts = pends - pcounts
    dest = pstarts[e_s] + (jnp.arange(A, dtype=jnp.int32) - starts[e_s])
    n_blocks = -(-A // MOE_BLOCK) + N_EXPERTS
    R = n_blocks * MOE_BLOCK
    row_tok = jnp.full((R,), T, jnp.int32).at[dest].set(t_s)
    row_w = jnp.zeros((R,), jnp.float32).at[dest].set(w_s)
    block_expert = jnp.minimum(jnp.searchsorted(pends, jnp.arange(n_blocks, dtype=jnp.int32) * MOE_BLOCK, side='right'), N_EXPERTS - 1).astype(jnp.int32)
    x_pad = jnp.concatenate([xt, jnp.zeros((1, D), xt.dtype)], axis=0)
    x_rows = x_pad[row_tok].reshape(n_blocks, MOE_BLOCK, D)

    def expert_block(args):
        xb, e = args
        hid = jax.nn.silu(xb @ w_gate[e]) * (xb @ w_up[e])
        return hid @ w_down[e]

    y = lax.map(expert_block, (x_rows, block_expert)).reshape(R, D)
    y = y * row_w[:, None].astype(y.dtype)
    out = jax.ops.segment_sum(y, row_tok, num_segments=T + 1)[:T]
    return out.reshape(B, S, D).astype(h.dtype)


def setup_inputs(seed: int = 0) -> dict:
    key = jax.random.key(seed)
    ks = jax.random.split(key, 17)
    f32 = jnp.float32
    L, D = DEPTH, D_MODEL
    nrm = lambda k, shape, scale: jax.random.normal(k, shape, f32) * scale
    return {
        "x": nrm(ks[0], (BATCH, SEQ, D), 1.0),
        "positions": jnp.broadcast_to(jnp.arange(SEQ, dtype=jnp.int32), (BATCH, SEQ)),
        "w_in": nrm(ks[1], (L, D, IN_WIDTH), D ** -0.5),
        "w_branch_attn": nrm(ks[2], (L, ATT_GROUP_WIDTH, D), ATT_GROUP_WIDTH ** -0.5),
        "w_branch_ret": nrm(ks[3], (L, RET_HEADS * RET_V_DIM, D), (RET_HEADS * RET_V_DIM) ** -0.5),
        "w_out": nrm(ks[4], (L, D, D), BETA * D ** -0.5),
        "ln1_scale": 1.0 + nrm(ks[5], (L, D), 0.02),
        "ln1_bias": nrm(ks[6], (L, D), 0.02),
        "w_group_router": nrm(ks[7], (L, D, N_EXPERT_GROUPS), D ** -0.5),
        "b_group_router": nrm(ks[8], (L, N_EXPERT_GROUPS), 0.01),
        "w_expert_router": nrm(ks[9], (L, N_EXPERT_GROUPS, D, EXPERTS_PER_GROUP), D ** -0.5),
        "b_expert_router": nrm(ks[10], (L, N_EXPERT_GROUPS, EXPERTS_PER_GROUP), 0.01),
        "w_expert_gate": nrm(ks[11], (L, N_EXPERTS, D, EXPERT_HIDDEN), D ** -0.5),
        "w_expert_up": nrm(ks[12], (L, N_EXPERTS, D, EXPERT_HIDDEN), D ** -0.5),
        "w_expert_down": nrm(ks[13], (L, N_EXPERTS, EXPERT_HIDDEN, D), BETA * EXPERT_HIDDEN ** -0.5),
        "ln2_scale": 1.0 + nrm(ks[14], (L, D), 0.02),
        "ln2_bias": nrm(ks[15], (L, D), 0.02),
    }


def reference(x, positions, w_in, w_branch_attn, w_branch_ret, w_out, ln1_scale, ln1_bias, w_group_router, b_group_router, w_expert_router, b_expert_router, w_expert_gate, w_expert_up, w_expert_down, ln2_scale, ln2_bias):
    for l in range(DEPTH):
        y = mixer_sublayer(x, positions, w_in[l], w_branch_attn[l], w_branch_ret[l], w_out[l])
        x = layer_norm(ALPHA * x + y, ln1_scale[l], ln1_bias[l])
        y = hierarchical_moe(x, w_group_router[l], b_group_router[l], w_expert_router[l], b_expert_router[l], w_expert_gate[l], w_expert_up[l], w_expert_down[l])
        x = layer_norm(ALPHA * x + y, ln2_scale[l], ln2_bias[l])
    return x
```

```cpp
#include <hip/hip_runtime.h>
#include <cstdio>
#include <cstdint>
#ifndef MK_SPLIT
#define MK_SPLIT 0
#endif
namespace pg8 {
#define PG8_LAS __attribute__((address_space(3)))
typedef unsigned short bf16_t;
typedef short bf16x8 __attribute__((ext_vector_type(8)));
typedef float f32x4 __attribute__((ext_vector_type(4)));
typedef unsigned u32x4 __attribute__((ext_vector_type(4)));
constexpr int BM = 256, BK = 64, HALF = 128, HTB = HALF * BK * 2  , STAGE_BYTES = 8 * HTB, NXCD = 8, WGM = 8;

__host__ __device__ __forceinline__ int lds_byte(int r, int c) { const int st = (r >> 4) * 2 + (c >> 5), rr = r & 15, cc = c & 31, ob = rr * 64 + cc * 2; return st * 1024 + (ob ^ (((ob >> 9) & 1) << 5)); }
__host__ __device__ __forceinline__ void stage_rc(int b, int& R, int& C) { const int st = b / 1024, sb = b % 1024, swz = sb ^ (((sb >> 9) & 1) << 5); R = (st >> 1) * 16 + swz / 64; C = (st & 1) * 32 + (swz % 64) / 2; }
__host__ __device__ __forceinline__ int perm32(int rho) { const int n = rho >> 4, i = rho & 15; return 8 * (i >> 2) + 4 * n + (i & 3); }

struct Unit { int pm, pn, e, lt; };
struct Gemm { const bf16_t* A; const bf16_t* Bt; int K; size_t bstride; };

struct StaticOrder {
    int nM, nN, nwg, G, c;
    __host__ __device__ void init(int M, int N, int G_, int c_) { nM = M / BM; nN = N / BM; nwg = nM * nN; G = G_; c = c_; }
    __host__ __device__ bool next(int i, Unit& u) const {
        const long L = (long)i * G + c; if (L >= nwg) return false;
        int wgid = (int)L; { const int q = nwg / NXCD, r = nwg % NXCD, xcd = wgid % NXCD, off = wgid / NXCD; wgid = (xcd < r ? xcd * (q + 1) : r * (q + 1) + (xcd - r) * q) + off; }
        const int nig = WGM * nN, gid = wgid / nig, fm = gid * WGM, gsz = (nM - fm) < WGM ? (nM - fm) : WGM;
        u.pm = fm + ((wgid % nig) % gsz); u.pn = (wgid % nig) / gsz; u.e = 0; u.lt = 0; return true;
    }
    __device__ __forceinline__ void a_rows(const Unit&, unsigned (&)[2][2], const int (&)[2], const int (&)[2], int) const {}
};
__device__ __forceinline__ unsigned cvt_pk_bf16(float lo, float hi) { unsigned r; asm volatile("v_cvt_pk_bf16_f32 %0, %1, %2" : "=v"(r) : "v"(lo), "v"(hi)); return r; }

template <class Epi, class Sched, bool ALIGN_EPI, bool GATHER>
__device__ __forceinline__ void gemm_phase(PG8_LAS unsigned char* lds, const Gemm g, const Sched& S, const Epi& E) {
    const int tid = threadIdx.x, wid = __builtin_amdgcn_readfirstlane(tid >> 6), lane = tid & 63, wr = wid >> 2, wc = wid & 3, fr = lane & 15, fq = lane >> 4;
    const int K = g.K, nt = K / BK;
    const size_t kstep = (size_t)(BK * 2);
    const size_t hstep = (size_t)HALF * K * 2;
    const size_t tstep = 2 * hstep;
    unsigned voffB[2], vA[2][2], vAn[2][2]; int RA[2], CA[2];
#pragma unroll
    for (int i = 0; i < 2; ++i) { int R, C; stage_rc(tid * 16 + i * 8192, R, C); const int Rb = (R & ~31) + perm32(R & 31);
        RA[i] = R; CA[i] = C; voffB[i] = (unsigned)(Rb * K + C) * 2u;
        vA[0][i] = (unsigned)(R * K + C) * 2u; vA[1][i] = vA[0][i] + (unsigned)hstep; vAn[0][i] = vA[0][i]; vAn[1][i] = vA[1][i]; }
    const unsigned ldsw = (unsigned)wid * 1024u;
    const int aoff = lds_byte(wr * 64 + fr, fq * 8), boff = lds_byte(wc * 32 + fr, fq * 8);
#define PG8_SA(b, h) (((b) * 2 + (h)) * HTB)
#define PG8_SB(b, h) ((4 + (b) * 2 + (h)) * HTB)
#define PG8_STAGE(bufoff, gbase, voff) do { _Pragma("unroll") for (int _i = 0; _i < 2; ++_i) \
        __builtin_amdgcn_global_load_lds((const unsigned*)((const char*)(gbase) + (voff)[_i]), (PG8_LAS unsigned*)(lds + (bufoff) + ldsw + _i * 8192), 16, 0, 0); } while (0)
#define PG8_LDA(dst, b, h) do { _Pragma("unroll") for (int m = 0; m < 4; ++m) _Pragma("unroll") for (int k = 0; k < 2; ++k) dst[m][k] = *(const PG8_LAS bf16x8*)(lds + PG8_SA(b, h) + aoff + m * 2048 + k * 1024); } while (0)
#define PG8_LDB(dst, b, h) do { _Pragma("unroll") for (int n = 0; n < 2; ++n) _Pragma("unroll") for (int k = 0; k < 2; ++k) dst[n][k] = *(const PG8_LAS bf16x8*)(lds + PG8_SB(b, h) + boff + n * 2048 + k * 1024); } while (0)
#define PG8_MMA(ai, bj, At, Bt) do { __builtin_amdgcn_s_setprio(1); _Pragma("unroll") for (int m = 0; m < 4; ++m) _Pragma("unroll") for (int n = 0; n < 2; ++n) _Pragma("unroll") for (int k = 0; k < 2; ++k) \
        acc[ai][bj][m][n] = __builtin_amdgcn_mfma_f32_16x16x32_bf16(Bt[n][k], At[m][k], acc[ai][bj][m][n], 0, 0, 0); __builtin_amdgcn_s_setprio(0); } while (0)
#define PG8_WAIT_V(n) asm volatile("s_waitcnt vmcnt(" #n ")" ::: "memory")
#define PG8_WAIT_L(n) asm volatile("s_waitcnt lgkmcnt(" #n ")" ::: "memory")
#define PG8_BAR __builtin_amdgcn_s_barrier()
#define PG8_SCHED __builtin_amdgcn_sched_barrier(0)
    Unit cur, nxt; int ui = 0;
    if (!S.next(0, cur)) return;
    f32x4 acc[2][2][4][2];
#pragma unroll
    for (int a = 0; a < 2; ++a)
#pragma unroll
        for (int b = 0; b < 2; ++b)
#pragma unroll
            for (int m = 0; m < 4; ++m)
#pragma unroll
                for (int n = 0; n < 2; ++n) acc[a][b][m][n] = (f32x4){0.f, 0.f, 0.f, 0.f};
    bf16x8 At[4][2], B0[2][2], B1[2][2];
    const char* cA = (const char*)g.A + (GATHER ? (size_t)0 : (size_t)cur.pm * tstep);
    const char* cB = (const char*)g.Bt + (size_t)cur.e * g.bstride + (size_t)cur.pn * tstep;
    if constexpr (GATHER) S.a_rows(cur, vA, RA, CA, K);
    PG8_STAGE(PG8_SB(0, 0), cB, voffB); PG8_STAGE(PG8_SB(0, 1), cB + hstep, voffB); PG8_STAGE(PG8_SA(0, 0), cA, vA[0]); PG8_STAGE(PG8_SA(0, 1), cA, vA[1]);
    if (wr == 1) PG8_BAR;
    PG8_WAIT_V(2); PG8_BAR;
    PG8_STAGE(PG8_SB(1, 0), cB + kstep, voffB); PG8_STAGE(PG8_SA(1, 0), cA + kstep, vA[0]); PG8_STAGE(PG8_SB(1, 1), cB + hstep + kstep, voffB);
    PG8_WAIT_V(6); PG8_BAR;
    for (;;) {
        const bool has_next = S.next(ui + 1, nxt);
        const char* nA = has_next ? (const char*)g.A + (GATHER ? (size_t)0 : (size_t)nxt.pm * tstep) : cA;
        const char* nB = has_next ? (const char*)g.Bt + (size_t)nxt.e * g.bstride + (size_t)nxt.pn * tstep : cB;
        if constexpr (GATHER) { if (has_next) S.a_rows(nxt, vAn, RA, CA, K); }
        for (int t = 0; t < nt; t += 2) {
            const bool last = (t == nt - 2);
            const char* a1 = cA + (size_t)(t + 1) * kstep;
            const char* a2 = last ? nA : cA + (size_t)(t + 2) * kstep; const char* b2 = last ? nB : cB + (size_t)(t + 2) * kstep;
            const char* a3 = a2 + kstep; const char* b3 = b2 + kstep;
            unsigned vX[2][2];
#pragma unroll
            for (int h = 0; h < 2; ++h)
#pragma unroll
                for (int i = 0; i < 2; ++i) vX[h][i] = (GATHER && last) ? vAn[h][i] : vA[h][i];
            PG8_LDB(B0, 0, 0); PG8_LDB(B1, 0, 1); PG8_SCHED; PG8_LDA(At, 0, 0); PG8_STAGE(PG8_SA(1, 1), a1, vA[1]);
            PG8_WAIT_V(8); PG8_WAIT_L(0); PG8_BAR; PG8_MMA(0, 0, At, B0); PG8_MMA(0, 1, At, B1); PG8_BAR; PG8_SCHED;
            PG8_LDA(At, 0, 1); PG8_STAGE(PG8_SB(0, 0), b2, voffB); PG8_STAGE(PG8_SB(0, 1), b2 + hstep, voffB); PG8_STAGE(PG8_SA(0, 0), a2, vX[0]);
            PG8_WAIT_V(8); PG8_WAIT_L(0); PG8_BAR; PG8_MMA(1, 0, At, B0); PG8_MMA(1, 1, At, B1); PG8_BAR; PG8_SCHED;
            PG8_LDB(B0, 1, 0); PG8_LDB(B1, 1, 1); PG8_SCHED; PG8_LDA(At, 1, 0); PG8_STAGE(PG8_SA(0, 1), a2, vX[1]);
            PG8_WAIT_V(8); PG8_WAIT_L(0); PG8_BAR; PG8_MMA(0, 0, At, B0); PG8_MMA(0, 1, At, B1); PG8_BAR; PG8_SCHED;
            PG8_LDA(At, 1, 1); PG8_STAGE(PG8_SB(1, 0), b3, voffB); PG8_STAGE(PG8_SB(1, 1), b3 + hstep, voffB); PG8_STAGE(PG8_SA(1, 0), a3, vX[0]);
            PG8_WAIT_V(8); PG8_WAIT_L(0); PG8_BAR; PG8_MMA(1, 0, At, B0); PG8_MMA(1, 1, At, B1); PG8_BAR; PG8_SCHED;
        }
        if constexpr (ALIGN_EPI) { if (wr == 0) PG8_BAR; }
        E(acc, cur, wr, wc, fr, fq);
        if (!has_next) break;
#pragma unroll
        for (int a = 0; a < 2; ++a)
#pragma unroll
            for (int b = 0; b < 2; ++b)
#pragma unroll
                for (int m = 0; m < 4; ++m)
#pragma unroll
                    for (int n = 0; n < 2; ++n) acc[a][b][m][n] = (f32x4){0.f, 0.f, 0.f, 0.f};
        cur = nxt; cA = nA; cB = nB; ++ui;
        if constexpr (GATHER) {
#pragma unroll
            for (int h = 0; h < 2; ++h)
#pragma unroll
                for (int i = 0; i < 2; ++i) vA[h][i] = vAn[h][i]; }
        if constexpr (ALIGN_EPI) { if (wr == 1) PG8_BAR; }
    }
    PG8_WAIT_V(0);
    if constexpr (!ALIGN_EPI) { if (wr == 0) PG8_BAR; }
    PG8_BAR;
#undef PG8_SA
#undef PG8_SB
#undef PG8_STAGE
#undef PG8_LDA
#undef PG8_LDB
#undef PG8_MMA
#undef PG8_WAIT_V
#undef PG8_WAIT_L
#undef PG8_BAR
#undef PG8_SCHED
}
}

constexpr int T = 8192, D = 2048, NIN = 19456;
constexpr int C_QA = 0, C_KA = 3072, C_VA = 6144, C_QR = 9216, C_KR = 10240, C_VR = 11264, C_GR = 13312, C_GA = 15360, C_GB = 17408;
constexpr int NEXP = 32, EHID = 512, LCAP = 8192;
constexpr float ALPHA = 1.189207115002721f;
constexpr float LN_EPS = 1e-5f;
constexpr float QK_SCALE = 0.08838834764831845f;
constexpr int NWAVES = 8;
constexpr size_t MiB = 1u << 20;
constexpr size_t WS_CTL = 0, CTL_ZERO_BYTES = 1 * MiB;
constexpr size_t WS_COSA = 1 * MiB, WS_SINA = WS_COSA + 512 * 1024, WS_COSR = 2 * MiB, WS_SINR = 4 * MiB;
constexpr size_t WS_ASGW = 6 * MiB, WS_ASGE = WS_ASGW + 64 * 1024, WS_LIST = WS_ASGW + 256 * 1024;
constexpr size_t WS_LSE = 7 * MiB + 512 * 1024;
constexpr size_t WS_WAT = 10 * MiB, WS_WRT = 14 * MiB, WS_WOT = 22 * MiB;
constexpr size_t WS_XB = 30 * MiB, WS_WINT = 62 * MiB;
constexpr size_t WS_PROJ = 138 * MiB;
constexpr size_t WS_OAG = 30 * MiB, WS_KV = 78 * MiB, WS_OA = 110 * MiB;
constexpr size_t WS_ST = 442 * MiB, WS_OR = 474 * MiB, WS_TMP = 506 * MiB, WS_MERGED = 570 * MiB;
constexpr size_t WS_WGU = 138 * MiB, WS_WD = 266 * MiB, WS_X1B = 330 * MiB, WS_HID = 362 * MiB, WS_YBUF = 386 * MiB;
constexpr size_t WS_END = 602 * MiB;
constexpr int CW_BAR = 4096;
constexpr int CW_CNT = 16384;
constexpr int RING_OFF = 0, RING_BYTES = 131072;
constexpr int LDSCTL_OFF = RING_BYTES, MISC_OFF = LDSCTL_OFF + 320;
constexpr int MOE_TAB_OFF = RING_BYTES + 1024, MOE_CNT_OFF = MOE_TAB_OFF + 512;
constexpr int LDS_BYTES = 147456;

#define GAS __attribute__((address_space(1)))
#define LAS __attribute__((address_space(3)))
typedef unsigned short bf16;
typedef unsigned v4u __attribute__((ext_vector_type(4)));
typedef unsigned v2u __attribute__((ext_vector_type(2)));
typedef float f32x4 __attribute__((ext_vector_type(4)));
typedef GAS unsigned gu32;
#define RLX_AGENT __ATOMIC_RELAXED, __HIP_MEMORY_SCOPE_AGENT
#define LDS_WAIT() asm volatile("s_waitcnt lgkmcnt(0)" ::: "memory")
#define VM_WAIT() asm volatile("s_waitcnt vmcnt(0)" ::: "memory")
__device__ __forceinline__ unsigned f2bf(float f) { unsigned u = __builtin_bit_cast(unsigned, f); return (u + 0x7fffu + ((u >> 16) & 1u)) >> 16; }
__device__ __forceinline__ unsigned pk2(float lo, float hi) { return f2bf(lo) | (f2bf(hi) << 16); }
__device__ __forceinline__ float bflo(unsigned w) { return __builtin_bit_cast(float, w << 16); }
__device__ __forceinline__ float bfhi(unsigned w) { return __builtin_bit_cast(float, w & 0xffff0000u); }
__device__ __forceinline__ float bf2f(bf16 b) { return __builtin_bit_cast(float, (unsigned)b << 16); }
__device__ __forceinline__ float wave_sum(float v) {
#pragma unroll
    for (int o = 1; o < 64; o <<= 1) v += __shfl_xor(v, o);
    return v;
}
__device__ __forceinline__ float wave_max(float v) {
#pragma unroll
    for (int o = 1; o < 64; o <<= 1) v = fmaxf(v, __shfl_xor(v, o));
    return v;
}
__device__ __forceinline__ float sigmoidf_(float x) { return 1.f / (1.f + __expf(-x)); }

#define XB_TMO      128
#define XB_XCNT(j)  (256  + 64 * (j))
#define XB_XSUB(j)  (1280 + 64 * (j))
#define XB_XGEN(j)  (2304 + 64 * (j))
#define XB_TOP      3328
#define XB_TOPGEN   3392
#define XCD_BAR_WORDS 3456
#define XB_SPIN_CAP (1u << 18)

__device__ __forceinline__ unsigned xb_ld(unsigned* p)              { return __hip_atomic_load(p, __ATOMIC_RELAXED, __HIP_MEMORY_SCOPE_AGENT); }
__device__ __forceinline__ unsigned xb_add(unsigned* p, unsigned v) { return __hip_atomic_fetch_add(p, v, __ATOMIC_RELAXED, __HIP_MEMORY_SCOPE_AGENT); }
__device__ __forceinline__ unsigned xb_xcc_id() { return (unsigned)__builtin_amdgcn_s_getreg((3 << 11) | 20) & 0xFu; }
#define XB_SPIN(cond, bar) do { unsigned _sp = 0; while (cond) { __builtin_amdgcn_s_sleep(1); \
    if ((++_sp & 255u) == 0u) { if (xb_ld(&(bar)[XB_TMO])) break; if (_sp > XB_SPIN_CAP) { atomicAdd(&(bar)[XB_TMO], 1u); break; } } } } while (0)

struct XcdBarrier {
    unsigned* bar; unsigned x;
    volatile LAS unsigned* st;
};

__device__ __forceinline__ XcdBarrier xcd_barrier_post(unsigned* bar, volatile LAS unsigned* st) {
    XcdBarrier b; b.bar = bar; b.x = xb_xcc_id(); b.st = st;
    if (threadIdx.x == 0) (void)xb_add(&bar[XB_XCNT(b.x)], 1u);
    return b;
}
__device__ __forceinline__ void xcd_barrier_complete(unsigned* bar, unsigned x, unsigned& nloc, unsigned& nx) {
    const unsigned G = gridDim.x * gridDim.y * gridDim.z;
    unsigned sum, cnt, mine, sp = 0u;
    for (;;) {
        sum = 0u; cnt = 0u; mine = 0u;
#pragma unroll
        for (unsigned j = 0; j < 16; ++j) { const unsigned c = xb_ld(&bar[XB_XCNT(j)]); sum += c; cnt += (c > 0u) ? 1u : 0u; mine = (j == x) ? c : mine; }
        if (sum == G) break;
        __builtin_amdgcn_s_sleep(1);
        if ((++sp & 255u) == 0u) { if (xb_ld(&bar[XB_TMO])) break; if (sp > XB_SPIN_CAP) { atomicAdd(&bar[XB_TMO], 1u); break; } }
    }
    nloc = mine > 0u ? mine : 1u; nx = cnt > 0u ? cnt : 1u;
}

__device__ __forceinline__ void xcd_barrier(const XcdBarrier& b) {
    asm volatile("s_waitcnt vmcnt(0)" ::: "memory");
    __syncthreads();
    if (threadIdx.x == 0) {
        unsigned* bar = b.bar;
        __builtin_amdgcn_s_waitcnt(0);
        unsigned nloc = b.st[0], nx = b.st[1];
        if (nloc == 0u) { xcd_barrier_complete(bar, b.x, nloc, nx); b.st[0] = nloc; b.st[1] = nx; }
        const unsigned old = xb_add(&bar[XB_XSUB(b.x)], 1u);
        const unsigned gen = old / nloc;
        if (old + 1u == (gen + 1u) * nloc) {
            __builtin_amdgcn_fence(__ATOMIC_RELEASE, "agent");
            asm volatile("s_waitcnt vmcnt(0)" ::: "memory");
            const unsigned og = xb_add(&bar[XB_TOP], 1u);
            const unsigned tg = og / nx;
            if (og + 1u == (tg + 1u) * nx) xb_add(&bar[XB_TOPGEN], 1u);
            else XB_SPIN(xb_ld(&bar[XB_TOPGEN]) == tg, bar);
            __builtin_amdgcn_fence(__ATOMIC_ACQUIRE, "agent");
            xb_add(&bar[XB_XGEN(b.x)], 1u);
            asm volatile("s_waitcnt vmcnt(0)" ::: "memory");
        } else {
            XB_SPIN(xb_ld(&bar[XB_XGEN(b.x)]) == gen, bar);
            __builtin_amdgcn_fence(__ATOMIC_ACQUIRE, "agent");
            asm volatile("s_waitcnt vmcnt(0)" ::: "memory");
        }
    }
    __syncthreads();
}

struct Frame {
    LAS unsigned char* lds;
    volatile LAS unsigned* MISC;
    gu32* ctl;
    int tid, lane, wave;
    int vcu, G;
    float* out; unsigned char* ws;
};
struct Args { const float* in[17]; float* out; unsigned char* ws; int ph_lo, ph_hi; };
#define WSP(type, off) ((type*)(F.ws + (off)))
enum { I_X = 0, I_POS, I_WIN, I_WBA, I_WBR, I_WOUT, I_LN1S, I_LN1B, I_WGR, I_BGR, I_WER, I_BER, I_WEG, I_WEU, I_WED, I_LN2S, I_LN2B };

__device__ __forceinline__ float logdecay(int h) { return log1pf(-exp2f(-5.f - (float)h)); }

__device__ __forceinline__ int win_src_col(int n) {
    if (n < C_VA) { int j = n & 127; if (j < 32) j = ((j & 1) << 4) + (j >> 1); return (n & ~127) + j; }
    if (n >= C_QR && n < C_VR) { int j = n & 127; j = ((j & 1) << 6) + (j >> 1); return (n & ~127) + j; }
    return n;
}
__device__ __forceinline__ void tr_item(const float* W, size_t ldw, int sc, int k0, bf16* WT, size_t ldt, int dr0, LAS float* scr, int lane) {
#pragma unroll 8
    for (int i = 0; i < 32; ++i) { const int kk = 2 * i + (lane >> 5); scr[kk * 33 + (lane & 31)] = W[(size_t)(k0 + kk) * ldw + sc]; }
    LDS_WAIT(); asm volatile("" ::: "memory");
    const int c = lane & 7;
#pragma unroll
    for (int j = 0; j < 4; ++j) { const int n = (lane >> 3) + 8 * j; const LAS float* s = scr + (8 * c) * 33 + n;
        v4u o; o.x = pk2(s[0 * 33], s[1 * 33]); o.y = pk2(s[2 * 33], s[3 * 33]); o.z = pk2(s[4 * 33], s[5 * 33]); o.w = pk2(s[6 * 33], s[7 * 33]);
        *(GAS v4u*)(WT + (size_t)(dr0 + n) * ldt + k0 + 8 * c) = o; }
    LDS_WAIT(); asm volatile("" ::: "memory");
}
__device__ __forceinline__ void p0_prologue(Frame& F, const Args& A) {
    LAS float* scr = (LAS float*)(F.lds + RING_OFF + F.wave * 16384);
    const int gw = F.vcu * NWAVES + F.wave, NGW = F.G * NWAVES;
    constexpr int I_IN = 32 * 608, I_A = 16 * 64, I_R = 32 * 64, I_O = 32 * 64, NITEMS = I_IN + I_A + I_R + I_O;
    for (int it = gw; it < NITEMS; it += NGW) {
        int r = it;
        if (r < I_IN) { const int kb = r / 608, nb = r % 608; tr_item(A.in[I_WIN], NIN, win_src_col(32 * nb + (F.lane & 31)), 64 * kb, WSP(bf16, WS_WINT), D, 32 * nb, scr, F.lane); continue; } r -= I_IN;
        if (r < I_A) { const int kb = r / 64, nb = r % 64; tr_item(A.in[I_WBA], D, 32 * nb + (F.lane & 31), 64 * kb, WSP(bf16, WS_WAT), 1024, 32 * nb, scr, F.lane); continue; } r -= I_A;
        if (r < I_R) { const int kb = r / 64, nb = r % 64; tr_item(A.in[I_WBR], D, 32 * nb + (F.lane & 31), 64 * kb, WSP(bf16, WS_WRT), 2048, 32 * nb, scr, F.lane); continue; } r -= I_R;
        { const int kb = r / 64, nb = r % 64; tr_item(A.in[I_WOUT], D, 32 * nb + (F.lane & 31), 64 * kb, WSP(bf16, WS_WOT), 2048, 32 * nb, scr, F.lane); }
    }
    const int gt = F.vcu * 512 + F.tid, NGT = F.G * 512;
    { const GAS f32x4* x4 = (const GAS f32x4*)A.in[I_X]; GAS v4u* xb = (GAS v4u*)WSP(bf16, WS_XB);
      for (int i = gt; i < T * D / 8; i += NGT) { const f32x4 a = x4[2 * i], b = x4[2 * i + 1]; v4u o; o.x = pk2(a.x, a.y); o.y = pk2(a.z, a.w); o.z = pk2(b.x, b.y); o.w = pk2(b.z, b.w); xb[i] = o; } }
    { const int* pos = (const int*)A.in[I_POS]; float* cA = WSP(float, WS_COSA); float* sA = WSP(float, WS_SINA); float* cR = WSP(float, WS_COSR); float* sR = WSP(float, WS_SINR);
      for (int i = gt; i < T * 80; i += NGT) { const int t = i / 80, j = i % 80;
        const double inv = (j < 16) ? exp(-((double)(2 * j) / 32.0) * 13.122363377404328)   : exp(-((double)(j - 16) / 63.0) * 9.210340371976184)  ;
        const double a = (double)pos[t] * inv, n = rint(a * 0.15915494309189535), r = a - n * 6.283185307179586;
        const float c = cosf((float)r), s = sinf((float)r);
        if (j < 16) { cA[t * 16 + j] = c; sA[t * 16 + j] = s; } else { cR[t * 64 + j - 16] = c; sR[t * 64 + j - 16] = s; } } }
}
#define EPI_LOOP_BEGIN const int row0 = u.pm * 256 + wr * 64 + fr; const int colw = wc * 32 + 8 * fq; \
    _Pragma("unroll") for (int ai = 0; ai < 2; ++ai) _Pragma("unroll") for (int m = 0; m < 4; ++m) { const int row = row0 + ai * 128 + m * 16; \
    _Pragma("unroll") for (int bj = 0; bj < 2; ++bj) { f32x4 v0 = acc[ai][bj][m][0], v1 = acc[ai][bj][m][1]; const int col = u.pn * 256 + bj * 128 + colw;
#define EPI_LOOP_END } }
__device__ __forceinline__ v4u pack8(const f32x4& v0, const f32x4& v1) { v4u w; w.x = pg8::cvt_pk_bf16(v0[0], v0[1]); w.y = pg8::cvt_pk_bf16(v0[2], v0[3]); w.z = pg8::cvt_pk_bf16(v1[0], v1[1]); w.w = pg8::cvt_pk_bf16(v1[2], v1[3]); return w; }
__device__ __forceinline__ void unpack8(const v4u w, f32x4& a, f32x4& b) { a = (f32x4){bflo(w.x), bfhi(w.x), bflo(w.y), bfhi(w.y)}; b = (f32x4){bflo(w.z), bfhi(w.z), bflo(w.w), bfhi(w.w)}; }
__device__ __forceinline__ void rot8(f32x4& v0, f32x4& v1, const f32x4 c, const f32x4 s) {
    float a, b;
    a = v0[0]; b = v0[1]; v0[0] = a * c[0] - b * s[0]; v0[1] = b * c[0] + a * s[0];
    a = v0[2]; b = v0[3]; v0[2] = a * c[1] - b * s[1]; v0[3] = b * c[1] + a * s[1];
    a = v1[0]; b = v1[1]; v1[0] = a * c[2] - b * s[2]; v1[1] = b * c[2] + a * s[2];
    a = v1[2]; b = v1[3]; v1[2] = a * c[3] - b * s[3]; v1[3] = b * c[3] + a * s[3];
}
struct EpiProj {
    bf16* O; const float *cosA, *sinA, *cosR, *sinR;
    __device__ __forceinline__ void operator()(const f32x4 (&acc)[2][2][4][2], const pg8::Unit& u, int wr, int wc, int fr, int fq) const {
        const int colt = u.pn * 256;
        int kind = 0;
        if (colt < C_VA) kind = 1; else if (colt < C_QR) kind = 0; else if (colt < C_KR) kind = 2; else if (colt < C_VR) kind = 3; else if (colt < C_GR) kind = 0; else if (colt < C_GA) kind = 4; else kind = 5;
        EPI_LOOP_BEGIN
            if (kind == 1) { if (wc == 0) { const f32x4 c = *(const f32x4*)(cosA + (size_t)row * 16 + 4 * fq), s = *(const f32x4*)(sinA + (size_t)row * 16 + 4 * fq); rot8(v0, v1, c, s); } }
            else if (kind == 2 || kind == 3) { const int i0 = wc * 16 + 4 * fq; const f32x4 c = *(const f32x4*)(cosR + (size_t)row * 64 + i0), s = *(const f32x4*)(sinR + (size_t)row * 64 + i0); rot8(v0, v1, c, s);
                if (kind == 3) { v0 = v0 * QK_SCALE; v1 = v1 * QK_SCALE; } }
            else if (kind == 4) {
#pragma unroll
                for (int j = 0; j < 4; ++j) { v0[j] = v0[j] * sigmoidf_(v0[j]); v1[j] = v1[j] * sigmoidf_(v1[j]); } }
            else if (kind == 5) {
#pragma unroll
                for (int j = 0; j < 4; ++j) { v0[j] = sigmoidf_(v0[j]); v1[j] = sigmoidf_(v1[j]); } }
            *(v4u*)(O + (size_t)row * NIN + col) = pack8(v0, v1);
        EPI_LOOP_END
    }
};
struct EpiTmp {
    float* tmp; const bf16* proj;
    __device__ __forceinline__ void operator()(const f32x4 (&acc)[2][2][4][2], const pg8::Unit& u, int wr, int wc, int fr, int fq) const {
        EPI_LOOP_BEGIN
            f32x4 g0, g1; unpack8(*(const v4u*)(proj + (size_t)row * NIN + C_GA + col), g0, g1);
            *(f32x4*)(tmp + (size_t)row * D + col) = v0 * g0; *(f32x4*)(tmp + (size_t)row * D + col + 4) = v1 * g1;
        EPI_LOOP_END
    }
};
struct EpiMerged {
    const float* tmp; const bf16* proj; bf16* merged;
    __device__ __forceinline__ void operator()(const f32x4 (&acc)[2][2][4][2], const pg8::Unit& u, int wr, int wc, int fr, int fq) const {
        EPI_LOOP_BEGIN
            f32x4 g0, g1; unpack8(*(const v4u*)(proj + (size_t)row * NIN + C_GB + col), g0, g1);
            const f32x4 t0 = *(const f32x4*)(tmp + (size_t)row * D + col), t1 = *(const f32x4*)(tmp + (size_t)row * D + col + 4);
            v0 = t0 + v0 * g0; v1 = t1 + v1 * g1;
            *(v4u*)(merged + (size_t)row * D + col) = pack8(v0, v1);
        EPI_LOOP_END
    }
};
struct EpiR1 {
    const float* x; float* r1;
    __device__ __forceinline__ void operator()(const f32x4 (&acc)[2][2][4][2], const pg8::Unit& u, int wr, int wc, int fr, int fq) const {
        EPI_LOOP_BEGIN
            const f32x4 x0 = *(const f32x4*)(x + (size_t)row * D + col), x1 = *(const f32x4*)(x + (size_t)row * D + col + 4);
            *(f32x4*)(r1 + (size_t)row * D + col) = x0 * ALPHA + v0; *(f32x4*)(r1 + (size_t)row * D + col + 4) = x1 * ALPHA + v1;
        EPI_LOOP_END
    }
};
__device__ __forceinline__ float dot128(const bf16* a, const bf16* b) {
    float s = 0.f;
#pragma unroll
    for (int x = 0; x < 16; ++x) { const v4u qa = *(const GAS v4u*)(a + 8 * x), kb = *(const GAS v4u*)(b + 8 * x);
        s += bflo(qa.x) * bflo(kb.x) + bfhi(qa.x) * bfhi(kb.x) + bflo(qa.y) * bflo(kb.y) + bfhi(qa.y) * bfhi(kb.y) + bflo(qa.z) * bflo(kb.z) + bfhi(qa.z) * bfhi(kb.z) + bflo(qa.w) * bflo(kb.w) + bfhi(qa.w) * bfhi(kb.w); }
    return s;
}
__device__ __forceinline__ void p2_attn_ref(Frame& F, const Args& A) {
    const bf16* proj = WSP(bf16, WS_PROJ); bf16* oag = WSP(bf16, WS_OAG); float* lse = WSP(float, WS_LSE);
    const int gw = F.vcu * NWAVES + F.wave, NGW = F.G * NWAVES, lane = F.lane;
    for (int it = gw; it < 3 * 8 * T; it += NGW) {
        const int g = it / (8 * T), rem = it % (8 * T), t = rem >> 3, h = rem & 7;
        const int d = (g == 0) ? 1 : (g == 1 ? 4 : 16);
        const int m = t / d, nk = (m < 128 ? m : 128) + 1;
        const size_t hc = (size_t)(g * 8 + h) * 128;
        const bf16* q = proj + (size_t)t * NIN + C_QA + hc;
        float sc[3];
#pragma unroll
        for (int j = 0; j < 3; ++j) { const int s = lane + 64 * j; float a = -__builtin_inff();
            if (s < nk) a = dot128(q, proj + (size_t)(t - s * d) * NIN + C_KA + hc) * QK_SCALE;
            sc[j] = a; }
        const float mx = wave_max(fmaxf(sc[0], fmaxf(sc[1], sc[2])));
        float p[3];
#pragma unroll
        for (int j = 0; j < 3; ++j) p[j] = (lane + 64 * j < nk) ? __expf(sc[j] - mx) : 0.f;
        const float sum = wave_sum(p[0] + p[1] + p[2]);
        float o0 = 0.f, o1 = 0.f;
        for (int s = 0; s < nk; ++s) { const float pj = (s < 64) ? p[0] : (s < 128 ? p[1] : p[2]); const float pv = __shfl(pj, s & 63);
            const unsigned vv = *(const GAS unsigned*)(proj + (size_t)(t - s * d) * NIN + C_VA + hc + 2 * lane); o0 += pv * bflo(vv); o1 += pv * bfhi(vv); }
        const float rs = 1.f / sum;
        *(GAS unsigned*)(oag + ((size_t)g * T + t) * 1024 + h * 128 + 2 * lane) = pk2(o0 * rs, o1 * rs);
        if (lane == 0) lse[((size_t)g * T + t) * 8 + h] = mx + __logf(sum);
    }
}
__device__ __forceinline__ void p2_kv_ref(Frame& F, const Args& A) {
    const bf16* proj = WSP(bf16, WS_PROJ); bf16* kvT = WSP(bf16, WS_KV);
    const int gt = F.vcu * 512 + F.tid, NGT = F.G * 512;
    for (int idx = gt; idx < 64 * 8 * 256 * 128; idx += NGT) {
        const int d = idx & 127, e = (idx >> 7) & 255, h = (idx >> 15) & 7, c = idx >> 18;
        const float ld = logdecay(h); float acc = 0.f;
        for (int m = 0; m < 128; ++m) { const size_t r = (size_t)(c * 128 + m) * NIN;
            acc += bf2f(proj[r + C_KR + h * 128 + d]) * __expf((float)(127 - m) * ld) * bf2f(proj[r + C_VR + h * 256 + e]); }
        kvT[idx] = (bf16)f2bf(acc);
    }
}
__device__ __forceinline__ void p3_scan_combine(Frame& F, const Args& A) {
    const int gt = F.vcu * 512 + F.tid, NGT = F.G * 512;
    { const GAS unsigned* kv = (const GAS unsigned*)WSP(bf16, WS_KV); GAS unsigned* st = (GAS unsigned*)WSP(bf16, WS_ST);
      for (int i = gt; i < 131072; i += NGT) {
        const int h = i >> 14; const float dc = __expf(128.f * logdecay(h)); float s0 = 0.f, s1 = 0.f;
#pragma unroll 8
        for (int c = 0; c < 64; ++c) { const unsigned w = kv[(size_t)c * 131072 + i]; st[(size_t)c * 131072 + i] = pk2(s0, s1); s0 = dc * s0 + bflo(w); s1 = dc * s1 + bfhi(w); } } }
    { const bf16* oag = WSP(bf16, WS_OAG); const float* lse = WSP(float, WS_LSE); bf16* oa = WSP(bf16, WS_OA);
      for (int i = gt; i < T * 128; i += NGT) {
        const int t = i >> 7, ch = i & 127, h = ch >> 4;
        const float l0 = lse[(size_t)t * 8 + h], l1 = lse[((size_t)T + t) * 8 + h], l2 = lse[((size_t)2 * T + t) * 8 + h];
        const float mx = fmaxf(l0, fmaxf(l1, l2)); const float e0 = __expf(l0 - mx), e1 = __expf(l1 - mx), e2 = __expf(l2 - mx); const float rs = 1.f / (e0 + e1 + e2);
        f32x4 a0, a1, b0, b1, c0, c1;
        unpack8(*(const GAS v4u*)(oag + (size_t)t * 1024 + ch * 8), a0, a1); unpack8(*(const GAS v4u*)(oag + ((size_t)T + t) * 1024 + ch * 8), b0, b1); unpack8(*(const GAS v4u*)(oag + ((size_t)2 * T + t) * 1024 + ch * 8), c0, c1);
        const f32x4 r0 = (a0 * e0 + b0 * e1 + c0 * e2) * rs, r1 = (a1 * e0 + b1 * e1 + c1 * e2) * rs;
        v4u o; o.x = pk2(r0[0], r0[1]); o.y = pk2(r0[2], r0[3]); o.z = pk2(r1[0], r1[1]); o.w = pk2(r1[2], r1[3]);
        *(GAS v4u*)(oa + (size_t)t * 1024 + ch * 8) = o; } }
}
__device__ __forceinline__ void p4_ret_ref(Frame& F, const Args& A) {
    const bf16* proj = WSP(bf16, WS_PROJ); const bf16* stT = WSP(bf16, WS_ST); bf16* orr = WSP(bf16, WS_OR);
    const int gw = F.vcu * NWAVES + F.wave, NGW = F.G * NWAVES, lane = F.lane;
    for (int it = gw; it < T * 8; it += NGW) {
        const int t = it >> 3, h = it & 7, n = t & 127, c = t >> 7; const float ld = logdecay(h);
        const bf16* q = proj + (size_t)t * NIN + C_QR + h * 128;
        float sc[2];
#pragma unroll
        for (int j = 0; j < 2; ++j) { const int m = lane + 64 * j; float a = 0.f;
            if (m <= n) a = dot128(q, proj + (size_t)(c * 128 + m) * NIN + C_KR + h * 128) * __expf((float)(n - m) * ld);
            sc[j] = a; }
        float o[4] = {0.f, 0.f, 0.f, 0.f};
        for (int m = 0; m <= n; ++m) { const float pv = __shfl((m < 64) ? sc[0] : sc[1], m & 63); const bf16* v = proj + (size_t)(c * 128 + m) * NIN + C_VR + h * 256;
#pragma unroll
            for (int j = 0; j < 4; ++j) o[j] += pv * bf2f(v[lane + 64 * j]); }
        const float qd = __expf((float)(n + 1) * ld);
#pragma unroll
        for (int j = 0; j < 4; ++j) { const int e = lane + 64 * j; o[j] += qd * dot128(q, stT + ((size_t)(c * 8 + h) * 256 + e) * 128); }
        const float mean = wave_sum(o[0] + o[1] + o[2] + o[3]) * (1.f / 256.f);
        float q2 = 0.f;
#pragma unroll
        for (int j = 0; j < 4; ++j) { o[j] -= mean; q2 += o[j] * o[j]; }
        const float rstd = 1.f / sqrtf(wave_sum(q2) * (1.f / 256.f) + LN_EPS);
#pragma unroll
        for (int j = 0; j < 4; ++j) { const int e = lane + 64 * j; orr[(size_t)t * D + h * 256 + e] = (bf16)f2bf(bf2f(proj[(size_t)t * NIN + C_GR + h * 256 + e]) * o[j] * rstd); }
    }
}
__device__ __forceinline__ void p7_ln_router(Frame& F, const Args& A) {
    const int gw = F.vcu * NWAVES + F.wave, NGW = F.G * NWAVES, lane = F.lane;
    float* x1 = F.out; bf16* x1b = WSP(bf16, WS_X1B); float* asgw = WSP(float, WS_ASGW); int* asge = WSP(int, WS_ASGE); int* list = WSP(int, WS_LIST);
    LAS float* xs = (LAS float*)(F.lds + RING_OFF + F.wave * 16384);
    for (int t = gw; t < T; t += NGW) {
        { const GAS f32x4* sc4 = (const GAS f32x4*)A.in[I_LN1S]; const GAS f32x4* bi4 = (const GAS f32x4*)A.in[I_LN1B];
          GAS f32x4* xr = (GAS f32x4*)(x1 + (size_t)t * D) + lane;
          f32x4 v[8]; float s = 0.f;
#pragma unroll
          for (int j = 0; j < 8; ++j) { v[j] = xr[64 * j]; s += (v[j].x + v[j].y) + (v[j].z + v[j].w); }
          const float mean = wave_sum(s) * (1.f / D); float s2 = 0.f;
#pragma unroll
          for (int j = 0; j < 8; ++j) { v[j] = v[j] - mean; s2 += (v[j].x * v[j].x + v[j].y * v[j].y) + (v[j].z * v[j].z + v[j].w * v[j].w); }
          const float rstd = 1.f / sqrtf(wave_sum(s2) * (1.f / D) + LN_EPS);
          GAS v2u* o8 = (GAS v2u*)(x1b + (size_t)t * D) + lane;
#pragma unroll
          for (int j = 0; j < 8; ++j) { v[j] = v[j] * rstd * sc4[lane + 64 * j] + bi4[lane + 64 * j]; xr[64 * j] = v[j];
              v2u w; w.x = pk2(v[j].x, v[j].y); w.y = pk2(v[j].z, v[j].w); o8[64 * j] = w; *(LAS f32x4*)(xs + 4 * (lane + 64 * j)) = v[j]; } }
        LDS_WAIT(); asm volatile("" ::: "memory");
        float gl[4] = {0.f, 0.f, 0.f, 0.f};
        { const GAS f32x4* wg4 = (const GAS f32x4*)A.in[I_WGR];
#pragma unroll 4
          for (int i = 0; i < 32; ++i) { const int dd = lane + 64 * i; const f32x4 wv = wg4[dd]; const float xv = xs[dd]; gl[0] += xv * wv.x; gl[1] += xv * wv.y; gl[2] += xv * wv.z; gl[3] += xv * wv.w; } }
        const float* bg = A.in[I_BGR];
#pragma unroll
        for (int q = 0; q < 4; ++q) gl[q] = wave_sum(gl[q]) + bg[q];
        int gs = 0; float gm = gl[0];
#pragma unroll
        for (int q = 1; q < 4; ++q) if (gl[q] > gm) { gm = gl[q]; gs = q; }
        const float pg = 1.f / (__expf(gl[0] - gm) + __expf(gl[1] - gm) + __expf(gl[2] - gm) + __expf(gl[3] - gm));
        float el[8] = {0.f, 0.f, 0.f, 0.f, 0.f, 0.f, 0.f, 0.f};
        { const GAS f32x4* we4 = (const GAS f32x4*)(A.in[I_WER] + (size_t)gs * D * 8);
#pragma unroll 4
          for (int i = 0; i < 32; ++i) { const int dd = lane + 64 * i; const f32x4 w0 = we4[dd * 2], w1 = we4[dd * 2 + 1]; const float xv = xs[dd];
              el[0] += xv * w0.x; el[1] += xv * w0.y; el[2] += xv * w0.z; el[3] += xv * w0.w; el[4] += xv * w1.x; el[5] += xv * w1.y; el[6] += xv * w1.z; el[7] += xv * w1.w; } }
        const float* be = A.in[I_BER];
#pragma unroll
        for (int q = 0; q < 8; ++q) el[q] = wave_sum(el[q]) + be[gs * 8 + q];
        int i1 = 0; float v1 = el[0];
#pragma unroll
        for (int q = 1; q < 8; ++q) if (el[q] > v1) { v1 = el[q]; i1 = q; }
        int i2 = -1; float v2 = -__builtin_inff();
#pragma unroll
        for (int q = 0; q < 8; ++q) if (q != i1 && el[q] > v2) { v2 = el[q]; i2 = q; }
        const float e2 = __expf(v2 - v1); const float w1 = pg / (1.f + e2), w2 = pg * e2 / (1.f + e2);
        if (lane < 2) { const int ex = gs * 8 + (lane == 0 ? i1 : i2); const int a = t * 2 + lane;
            const unsigned pos = __hip_atomic_fetch_add((unsigned*)(F.ctl + CW_CNT + 64 * ex), 1u, RLX_AGENT);
            list[ex * LCAP + pos] = a; asgw[a] = (lane == 0) ? w1 : w2; asge[a] = ex; }
        LDS_WAIT(); asm volatile("" ::: "memory");
    }
}
__device__ __forceinline__ void p7_expert_weights(Frame& F, const Args& A) {
    LAS float* scr = (LAS float*)(F.lds + RING_OFF + F.wave * 16384);
    const int gw = F.vcu * NWAVES + F.wave, NGW = F.G * NWAVES;
    for (int it = gw; it < NEXP * 1536; it += NGW) {
        const int e = it / 1536; int r = it % 1536;
        if (r < 1024) { const int up = r >> 9; r &= 511; const int kb = r >> 4, nb = r & 15, n0 = 32 * nb;
            tr_item(A.in[up ? I_WEU : I_WEG] + (size_t)e * D * EHID, EHID, n0 + (F.lane & 31), 64 * kb, WSP(bf16, WS_WGU) + (size_t)e * 1024 * D, D, 256 * (n0 >> 7) + 128 * up + (n0 & 127), scr, F.lane); }
        else { r -= 1024; const int kb = r >> 6, nb = r & 63;
            tr_item(A.in[I_WED] + (size_t)e * EHID * D, D, 32 * nb + (F.lane & 31), 64 * kb, WSP(bf16, WS_WD) + (size_t)e * D * EHID, EHID, 32 * nb, scr, F.lane); }
    }
}
__device__ __forceinline__ float dotn(const bf16* a, const bf16* b, int n8) {
    float s = 0.f;
    for (int x = 0; x < n8; ++x) { const v4u qa = *(const GAS v4u*)(a + 8 * x), kb = *(const GAS v4u*)(b + 8 * x);
        s += bflo(qa.x) * bflo(kb.x) + bfhi(qa.x) * bfhi(kb.x) + bflo(qa.y) * bflo(kb.y) + bfhi(qa.y) * bfhi(kb.y) + bflo(qa.z) * bflo(kb.z) + bfhi(qa.z) * bfhi(kb.z) + bflo(qa.w) * bflo(kb.w) + bfhi(qa.w) * bfhi(kb.w); }
    return s;
}
__device__ __forceinline__ void p8_moe_ref(Frame& F, const Args& A) {
    const bf16* x1b = WSP(bf16, WS_X1B); const bf16* wgu = WSP(bf16, WS_WGU); const bf16* wd = WSP(bf16, WS_WD); const float* asgw = WSP(float, WS_ASGW); const int* asge = WSP(int, WS_ASGE);
    bf16* hidg = WSP(bf16, WS_HID); bf16* yb = WSP(bf16, WS_YBUF);
    const int gw = F.vcu * NWAVES + F.wave, NGW = F.G * NWAVES, lane = F.lane;
    for (int a = gw; a < 2 * T; a += NGW) {
        const int t = a >> 1, e = asge[a]; const float w = asgw[a];
        const bf16* xr = x1b + (size_t)t * D; const bf16* wg = wgu + (size_t)e * 1024 * D; bf16* hrow = hidg + (size_t)a * EHID;
#pragma unroll 1
        for (int i = 0; i < 8; ++i) { const int j = lane + 64 * i; const bf16* gr = wg + (size_t)(256 * (j >> 7) + (j & 127)) * D;
            const float gv = dotn(xr, gr, 256), uv = dotn(xr, gr + (size_t)128 * D, 256); hrow[j] = (bf16)f2bf(gv * sigmoidf_(gv) * uv); }
        VM_WAIT(); __builtin_amdgcn_fence(__ATOMIC_RELEASE, "workgroup"); __builtin_amdgcn_fence(__ATOMIC_ACQUIRE, "agent");
        const bf16* wdr = wd + (size_t)e * D * EHID;
#pragma unroll 1
        for (int i = 0; i < 32; ++i) { const int col = lane + 64 * i; yb[(size_t)a * D + col] = (bf16)f2bf(w * dotn(hrow, wdr + (size_t)col * EHID, 64)); }
    }
}
__device__ __forceinline__ void p10_final(Frame& F, const Args& A) {
    const int gw = F.vcu * NWAVES + F.wave, NGW = F.G * NWAVES, lane = F.lane;
    const bf16* yb = WSP(bf16, WS_YBUF);
    const GAS f32x4* sc4 = (const GAS f32x4*)A.in[I_LN2S]; const GAS f32x4* bi4 = (const GAS f32x4*)A.in[I_LN2B];
    for (int t = gw; t < T; t += NGW) {
        GAS f32x4* xr = (GAS f32x4*)(F.out + (size_t)t * D) + lane;
        const GAS v2u* y0 = (const GAS v2u*)(yb + (size_t)(2 * t) * D) + lane; const GAS v2u* y1 = (const GAS v2u*)(yb + (size_t)(2 * t + 1) * D) + lane;
        f32x4 v[8]; float s = 0.f;
#pragma unroll
        for (int j = 0; j < 8; ++j) { const f32x4 xv = xr[64 * j]; const v2u a = y0[64 * j], b = y1[64 * j];
            v[j] = xv * ALPHA + (f32x4){bflo(a.x) + bflo(b.x), bfhi(a.x) + bfhi(b.x), bflo(a.y) + bflo(b.y), bfhi(a.y) + bfhi(b.y)};
            s += (v[j].x + v[j].y) + (v[j].z + v[j].w); }
        const float mean = wave_sum(s) * (1.f / D); float s2 = 0.f;
#pragma unroll
        for (int j = 0; j < 8; ++j) { v[j] = v[j] - mean; s2 += (v[j].x * v[j].x + v[j].y * v[j].y) + (v[j].z * v[j].z + v[j].w * v[j].w); }
        const float rstd = 1.f / sqrtf(wave_sum(s2) * (1.f / D) + LN_EPS);
#pragma unroll
        for (int j = 0; j < 8; ++j) xr[64 * j] = v[j] * rstd * sc4[lane + 64 * j] + bi4[lane + 64 * j];
    }
}

constexpr int N_PHASES = 11;
__global__ void __launch_bounds__(NWAVES * 64, 2) fwd_kernel(Args args) {
    extern __shared__ __attribute__((aligned(16))) unsigned char lds[];
    Frame F;
    F.lds = (LAS unsigned char*)lds;
    F.MISC = (volatile LAS unsigned*)(F.lds + MISC_OFF);
    F.tid = threadIdx.x; F.lane = F.tid & 63; F.wave = __builtin_amdgcn_readfirstlane(F.tid >> 6);
    F.G = gridDim.x; { const int bx = blockIdx.x; F.vcu = (F.G % 8 == 0) ? (bx % 8) * (F.G / 8) + bx / 8 : bx; }
    F.ws = args.ws; F.ctl = (gu32*)(args.ws + WS_CTL); F.out = args.out;
    const Args& A = args;
    for (int u = F.tid; u < (LDS_BYTES - LDSCTL_OFF) / 4; u += NWAVES * 64) ((LAS unsigned*)(F.lds + LDSCTL_OFF))[u] = 0u;
    __syncthreads();
    XcdBarrier bar; bar.bar = (unsigned*)(F.ctl + CW_BAR); bar.x = 0; bar.st = nullptr;
    if (!MK_SPLIT) bar = xcd_barrier_post((unsigned*)(F.ctl + CW_BAR), F.MISC + 8);
    const int lo = args.ph_lo, hi = args.ph_hi;
#ifndef PH_MASK
#define PH_MASK 0xFFFF
#endif
#define IN(k) (((PH_MASK >> (k)) & 1) && lo <= (k) && (k) < hi)
#define SEAM(k) do { if (IN(k) && IN((k) + 1)) xcd_barrier(bar); } while (0)

    if (IN(0)) { p0_prologue(F, A); } SEAM(0);
    if (IN(1)) {
        pg8::Gemm g{WSP(bf16, WS_XB), WSP(bf16, WS_WINT), D, 0}; pg8::StaticOrder S; S.init(T, NIN, F.G, (int)blockIdx.x);
        EpiProj E{WSP(bf16, WS_PROJ), WSP(float, WS_COSA), WSP(float, WS_SINA), WSP(float, WS_COSR), WSP(float, WS_SINR)};
        pg8::gemm_phase<EpiProj, pg8::StaticOrder, true, false>(F.lds + RING_OFF, g, S, E);
    } SEAM(1);
    if (IN(2)) { p2_attn_ref(F, A); p2_kv_ref(F, A); } SEAM(2);
    if (IN(3)) { p3_scan_combine(F, A); } SEAM(3);
    if (IN(4)) { p4_ret_ref(F, A); } SEAM(4);
    if (IN(5)) {
        { pg8::Gemm g{WSP(bf16, WS_OA), WSP(bf16, WS_WAT), 1024, 0}; pg8::StaticOrder S; S.init(T, D, F.G, (int)blockIdx.x);
          EpiTmp E{WSP(float, WS_TMP), WSP(bf16, WS_PROJ)};
          pg8::gemm_phase<EpiTmp, pg8::StaticOrder, true, false>(F.lds + RING_OFF, g, S, E); }
        { pg8::Gemm g{WSP(bf16, WS_OR), WSP(bf16, WS_WRT), 2048, 0}; pg8::StaticOrder S; S.init(T, D, F.G, (int)blockIdx.x);
          EpiMerged E{WSP(float, WS_TMP), WSP(bf16, WS_PROJ), WSP(bf16, WS_MERGED)};
          pg8::gemm_phase<EpiMerged, pg8::StaticOrder, true, false>(F.lds + RING_OFF, g, S, E); }
    } SEAM(5);
    if (IN(6)) {
        pg8::Gemm g{WSP(bf16, WS_MERGED), WSP(bf16, WS_WOT), 2048, 0}; pg8::StaticOrder S; S.init(T, D, F.G, (int)blockIdx.x);
        EpiR1 E{A.in[I_X], F.out};
        pg8::gemm_phase<EpiR1, pg8::StaticOrder, true, false>(F.lds + RING_OFF, g, S, E);
    } SEAM(6);
    if (IN(7)) { p7_ln_router(F, A); p7_expert_weights(F, A); } SEAM(7);
    if (IN(8)) { p8_moe_ref(F, A); } SEAM(8);
    if (IN(9)) { } SEAM(9);
    if (IN(10)) { p10_final(F, A); }
#undef IN
#undef SEAM
}

extern "C" void kernel_launch(void* const* d_in, const int* in_sizes, int n_in, void* d_out, int out_size, void* d_ws, size_t ws_size, hipStream_t stream) {
    static int grid = 0;
    if (grid == 0) {
        if (n_in != 17 || in_sizes[0] != T * D || out_size != T * D || ws_size < WS_END) { fprintf(stderr, "kernel_launch: unexpected shapes (n_in %d, in0 %d, out %d, ws %zu < %zu); nothing launched\n", n_in, n_in > 0 ? in_sizes[0] : -1, out_size, ws_size, (size_t)WS_END); grid = -1; return; }
        int dev = 0, cus = 0, per_cu = 0;
        if (hipGetDevice(&dev) != hipSuccess || hipDeviceGetAttribute(&cus, hipDeviceAttributeMultiprocessorCount, dev) != hipSuccess) { grid = -1; return; }
        if (hipFuncSetAttribute((const void*)fwd_kernel, hipFuncAttributeMaxDynamicSharedMemorySize, LDS_BYTES) != hipSuccess) { fprintf(stderr, "kernel_launch: hipFuncSetAttribute failed\n"); grid = -1; return; }
        if (hipOccupancyMaxActiveBlocksPerMultiprocessor(&per_cu, (const void*)fwd_kernel, NWAVES * 64, LDS_BYTES) != hipSuccess || per_cu < 1)
            fprintf(stderr, "kernel_launch: note: occupancy query reports %d workgroups per CU\n", per_cu);
        (void)hipGetLastError();
        grid = cus;
    }
    if (grid < 0) return;
    if (hipMemsetAsync((char*)d_ws + WS_CTL, 0, CTL_ZERO_BYTES, stream) != hipSuccess) return;
    Args a{};
    for (int i = 0; i < 17; ++i) a.in[i] = (const float*)d_in[i];
    a.out = (float*)d_out; a.ws = (unsigned char*)d_ws;
#if MK_SPLIT
    for (int p = 0; p < N_PHASES; ++p) { a.ph_lo = p; a.ph_hi = p + 1; hipLaunchKernelGGL(fwd_kernel, dim3(grid), dim3(NWAVES * 64), LDS_BYTES, stream, a); }
#else
    a.ph_lo = 0; a.ph_hi = N_PHASES;
    hipLaunchKernelGGL(fwd_kernel, dim3(grid), dim3(NWAVES * 64), LDS_BYTES, stream, a);
#endif
    const hipError_t le = hipPeekAtLastError();
    if (le != hipSuccess) fprintf(stderr, "kernel_launch: launch failed: %s\n", hipGetErrorName(le));
}
```

```cpp
#include <hip/hip_runtime.h>
#include <cstdio>
#include <cstdint>
#ifndef MK_SPLIT
#define MK_SPLIT 0
#endif
namespace pg8 {
#define PG8_LAS __attribute__((address_space(3)))
typedef unsigned short bf16_t;
typedef short bf16x8 __attribute__((ext_vector_type(8)));
typedef float f32x4 __attribute__((ext_vector_type(4)));
typedef unsigned u32x4 __attribute__((ext_vector_type(4)));
constexpr int BM = 256, BK = 64, HALF = 128, HTB = HALF * BK * 2  , STAGE_BYTES = 8 * HTB, NXCD = 8, WGM = 8;

__host__ __device__ __forceinline__ int lds_byte(int r, int c) { const int st = (r >> 4) * 2 + (c >> 5), rr = r & 15, cc = c & 31, ob = rr * 64 + cc * 2; return st * 1024 + (ob ^ (((ob >> 9) & 1) << 5)); }
__host__ __device__ __forceinline__ void stage_rc(int b, int& R, int& C) { const int st = b / 1024, sb = b % 1024, swz = sb ^ (((sb >> 9) & 1) << 5); R = (st >> 1) * 16 + swz / 64; C = (st & 1) * 32 + (swz % 64) / 2; }
__host__ __device__ __forceinline__ int perm32(int rho) { const int n = rho >> 4, i = rho & 15; return 8 * (i >> 2) + 4 * n + (i & 3); }

struct Unit { int pm, pn, e, lt; };
struct Gemm { const bf16_t* A; const bf16_t* Bt; int K; size_t bstride; };

struct StaticOrder {
    int nM, nN, nwg, G, c;
    __host__ __device__ void init(int M, int N, int G_, int c_) { nM = M / BM; nN = N / BM; nwg = nM * nN; G = G_; c = c_; }
    __host__ __device__ bool next(int i, Unit& u) const {
        const long L = (long)i * G + c; if (L >= nwg) return false;
        int wgid = (int)L; { const int q = nwg / NXCD, r = nwg % NXCD, xcd = wgid % NXCD, off = wgid / NXCD; wgid = (xcd < r ? xcd * (q + 1) : r * (q + 1) + (xcd - r) * q) + off; }
        const int nig = WGM * nN, gid = wgid / nig, fm = gid * WGM, gsz = (nM - fm) < WGM ? (nM - fm) : WGM;
        u.pm = fm + ((wgid % nig) % gsz); u.pn = (wgid % nig) / gsz; u.e = 0; u.lt = 0; return true;
    }
    __device__ __forceinline__ void a_rows(const Unit&, unsigned (&)[2][2], const int (&)[2], const int (&)[2], int) const {}
};
__device__ __forceinline__ unsigned cvt_pk_bf16(float lo, float hi) { unsigned r; asm volatile("v_cvt_pk_bf16_f32 %0, %1, %2" : "=v"(r) : "v"(lo), "v"(hi)); return r; }

template <class Epi, class Sched, bool ALIGN_EPI, bool GATHER>
__device__ __forceinline__ void gemm_phase(PG8_LAS unsigned char* lds, const Gemm g, const Sched& S, const Epi& E) {
    const int tid = threadIdx.x, wid = __builtin_amdgcn_readfirstlane(tid >> 6), lane = tid & 63, wr = wid >> 2, wc = wid & 3, fr = lane & 15, fq = lane >> 4;
    const int K = g.K, nt = K / BK;
    const size_t kstep = (size_t)(BK * 2);
    const size_t hstep = (size_t)HALF * K * 2;
    const size_t tstep = 2 * hstep;
    unsigned voffB[2], vA[2][2], vAn[2][2]; int RA[2], CA[2];
#pragma unroll
    for (int i = 0; i < 2; ++i) { int R, C; stage_rc(tid * 16 + i * 8192, R, C); const int Rb = (R & ~31) + perm32(R & 31);
        RA[i] = R; CA[i] = C; voffB[i] = (unsigned)(Rb * K + C) * 2u;
        vA[0][i] = (unsigned)(R * K + C) * 2u; vA[1][i] = vA[0][i] + (unsigned)hstep; vAn[0][i] = vA[0][i]; vAn[1][i] = vA[1][i]; }
    const unsigned ldsw = (unsigned)wid * 1024u;
    const int aoff = lds_byte(wr * 64 + fr, fq * 8), boff = lds_byte(wc * 32 + fr, fq * 8);
#define PG8_SA(b, h) (((b) * 2 + (h)) * HTB)
#define PG8_SB(b, h) ((4 + (b) * 2 + (h)) * HTB)
#define PG8_STAGE(bufoff, gbase, voff) do { _Pragma("unroll") for (int _i = 0; _i < 2; ++_i) \
        __builtin_amdgcn_global_load_lds((const unsigned*)((const char*)(gbase) + (voff)[_i]), (PG8_LAS unsigned*)(lds + (bufoff) + ldsw + _i * 8192), 16, 0, 0); } while (0)
#define PG8_LDA(dst, b, h) do { _Pragma("unroll") for (int m = 0; m < 4; ++m) _Pragma("unroll") for (int k = 0; k < 2; ++k) dst[m][k] = *(const PG8_LAS bf16x8*)(lds + PG8_SA(b, h) + aoff + m * 2048 + k * 1024); } while (0)
#define PG8_LDB(dst, b, h) do { _Pragma("unroll") for (int n = 0; n < 2; ++n) _Pragma("unroll") for (int k = 0; k < 2; ++k) dst[n][k] = *(const PG8_LAS bf16x8*)(lds + PG8_SB(b, h) + boff + n * 2048 + k * 1024); } while (0)
#define PG8_MMA(ai, bj, At, Bt) do { __builtin_amdgcn_s_setprio(1); _Pragma("unroll") for (int m = 0; m < 4; ++m) _Pragma("unroll") for (int n = 0; n < 2; ++n) _Pragma("unroll") for (int k = 0; k < 2; ++k) \
        acc[ai][bj][m][n] = __builtin_amdgcn_mfma_f32_16x16x32_bf16(Bt[n][k], At[m][k], acc[ai][bj][m][n], 0, 0, 0); __builtin_amdgcn_s_setprio(0); } while (0)
#define PG8_WAIT_V(n) asm volatile("s_waitcnt vmcnt(" #n ")" ::: "memory")
#define PG8_WAIT_L(n) asm volatile("s_waitcnt lgkmcnt(" #n ")" ::: "memory")
#define PG8_BAR __builtin_amdgcn_s_barrier()
#define PG8_SCHED __builtin_amdgcn_sched_barrier(0)
    Unit cur, nxt; int ui = 0;
    if (!S.next(0, cur)) return;
    f32x4 acc[2][2][4][2];
#pragma unroll
    for (int a = 0; a < 2; ++a)
#pragma unroll
        for (int b = 0; b < 2; ++b)
#pragma unroll
            for (int m = 0; m < 4; ++m)
#pragma unroll
                for (int n = 0; n < 2; ++n) acc[a][b][m][n] = (f32x4){0.f, 0.f, 0.f, 0.f};
    bf16x8 At[4][2], B0[2][2], B1[2][2];
    const char* cA = (const char*)g.A + (GATHER ? (size_t)0 : (size_t)cur.pm * tstep);
    const char* cB = (const char*)g.Bt + (size_t)cur.e * g.bstride + (size_t)cur.pn * tstep;
    if constexpr (GATHER) S.a_rows(cur, vA, RA, CA, K);
    PG8_STAGE(PG8_SB(0, 0), cB, voffB); PG8_STAGE(PG8_SB(0, 1), cB + hstep, voffB); PG8_STAGE(PG8_SA(0, 0), cA, vA[0]); PG8_STAGE(PG8_SA(0, 1), cA, vA[1]);
    if (wr == 1) PG8_BAR;
    PG8_WAIT_V(2); PG8_BAR;
    PG8_STAGE(PG8_SB(1, 0), cB + kstep, voffB); PG8_STAGE(PG8_SA(1, 0), cA + kstep, vA[0]); PG8_STAGE(PG8_SB(1, 1), cB + hstep + kstep, voffB);
    PG8_WAIT_V(6); PG8_BAR;
    for (;;) {
        const bool has_next = S.next(ui + 1, nxt);
        const char* nA = has_next ? (const char*)g.A + (GATHER ? (size_t)0 : (size_t)nxt.pm * tstep) : cA;
        const char* nB = has_next ? (const char*)g.Bt + (size_t)nxt.e * g.bstride + (size_t)nxt.pn * tstep : cB;
        if constexpr (GATHER) { if (has_next) S.a_rows(nxt, vAn, RA, CA, K); }
        for (int t = 0; t < nt; t += 2) {
            const bool last = (t == nt - 2);
            const char* a1 = cA + (size_t)(t + 1) * kstep;
            const char* a2 = last ? nA : cA + (size_t)(t + 2) * kstep; const char* b2 = last ? nB : cB + (size_t)(t + 2) * kstep;
            const char* a3 = a2 + kstep; const char* b3 = b2 + kstep;
            unsigned vX[2][2];
#pragma unroll
            for (int h = 0; h < 2; ++h)
#pragma unroll
                for (int i = 0; i < 2; ++i) vX[h][i] = (GATHER && last) ? vAn[h][i] : vA[h][i];
            PG8_LDB(B0, 0, 0); PG8_LDB(B1, 0, 1); PG8_SCHED; PG8_LDA(At, 0, 0); PG8_STAGE(PG8_SA(1, 1), a1, vA[1]);
            PG8_WAIT_V(8); PG8_WAIT_L(0); PG8_BAR; PG8_MMA(0, 0, At, B0); PG8_MMA(0, 1, At, B1); PG8_BAR; PG8_SCHED;
            PG8_LDA(At, 0, 1); PG8_STAGE(PG8_SB(0, 0), b2, voffB); PG8_STAGE(PG8_SB(0, 1), b2 + hstep, voffB); PG8_STAGE(PG8_SA(0, 0), a2, vX[0]);
            PG8_WAIT_V(8); PG8_WAIT_L(0); PG8_BAR; PG8_MMA(1, 0, At, B0); PG8_MMA(1, 1, At, B1); PG8_BAR; PG8_SCHED;
            PG8_LDB(B0, 1, 0); PG8_LDB(B1, 1, 1); PG8_SCHED; PG8_LDA(At, 1, 0); PG8_STAGE(PG8_SA(0, 1), a2, vX[1]);
            PG8_WAIT_V(8); PG8_WAIT_L(0); PG8_BAR; PG8_MMA(0, 0, At, B0); PG8_MMA(0, 1, At, B1); PG8_BAR; PG8_SCHED;
            PG8_LDA(At, 1, 1); PG8_STAGE(PG8_SB(1, 0), b3, voffB); PG8_STAGE(PG8_SB(1, 1), b3 + hstep, voffB); PG8_STAGE(PG8_SA(1, 0), a3, vX[0]);
            PG8_WAIT_V(8); PG8_WAIT_L(0); PG8_BAR; PG8_MMA(1, 0, At, B0); PG8_MMA(1, 1, At, B1); PG8_BAR; PG8_SCHED;
        }
        if constexpr (ALIGN_EPI) { if (wr == 0) PG8_BAR; }
        E(acc, cur, wr, wc, fr, fq);
        if (!has_next) break;
#pragma unroll
        for (int a = 0; a < 2; ++a)
#pragma unroll
            for (int b = 0; b < 2; ++b)
#pragma unroll
                for (int m = 0; m < 4; ++m)
#pragma unroll
                    for (int n = 0; n < 2; ++n) acc[a][b][m][n] = (f32x4){0.f, 0.f, 0.f, 0.f};
        cur = nxt; cA = nA; cB = nB; ++ui;
        if constexpr (GATHER) {
#pragma unroll
            for (int h = 0; h < 2; ++h)
#pragma unroll
                for (int i = 0; i < 2; ++i) vA[h][i] = vAn[h][i]; }
        if constexpr (ALIGN_EPI) { if (wr == 1) PG8_BAR; }
    }
    PG8_WAIT_V(0);
    if constexpr (!ALIGN_EPI) { if (wr == 0) PG8_BAR; }
    PG8_BAR;
#undef PG8_SA
#undef PG8_SB
#undef PG8_STAGE
#undef PG8_LDA
#undef PG8_LDB
#undef PG8_MMA
#undef PG8_WAIT_V
#undef PG8_WAIT_L
#undef PG8_BAR
#undef PG8_SCHED
}
}

constexpr int T = 8192, D = 2048, NIN = 19456;
constexpr int C_QA = 0, C_KA = 3072, C_VA = 6144, C_QR = 9216, C_KR = 10240, C_VR = 11264, C_GR = 13312, C_GA = 15360, C_GB = 17408;
constexpr int NEXP = 32, EHID = 512, LCAP = 8192;
constexpr float ALPHA = 1.189207115002721f;
constexpr float LN_EPS = 1e-5f;
constexpr float QK_SCALE = 0.08838834764831845f;
constexpr int NWAVES = 8;
constexpr size_t MiB = 1u << 20;
constexpr size_t WS_CTL = 0, CTL_ZERO_BYTES = 1 * MiB;
constexpr size_t WS_COSA = 1 * MiB, WS_SINA = WS_COSA + 512 * 1024, WS_COSR = 2 * MiB, WS_SINR = 4 * MiB;
constexpr size_t WS_ASGW = 6 * MiB, WS_ASGE = WS_ASGW + 64 * 1024, WS_LIST = WS_ASGW + 256 * 1024;
constexpr size_t WS_LSE = 7 * MiB + 512 * 1024;
constexpr size_t WS_WAT = 10 * MiB, WS_WRT = 14 * MiB, WS_WOT = 22 * MiB;
constexpr size_t WS_XB = 30 * MiB, WS_WINT = 62 * MiB;
constexpr size_t WS_PROJ = 138 * MiB;
constexpr size_t WS_OAG = 30 * MiB, WS_KV = 78 * MiB, WS_OA = 110 * MiB;
constexpr size_t WS_ST = 442 * MiB, WS_OR = 474 * MiB, WS_TMP = 506 * MiB, WS_MERGED = 570 * MiB;
constexpr size_t WS_WGU = 138 * MiB, WS_WD = 266 * MiB, WS_X1B = 330 * MiB, WS_HID = 362 * MiB, WS_YBUF = 386 * MiB;
constexpr size_t WS_END = 602 * MiB;
constexpr int CW_BAR = 4096;
constexpr int CW_CNT = 16384;
constexpr int RING_OFF = 0, RING_BYTES = 131072;
constexpr int LDSCTL_OFF = RING_BYTES, MISC_OFF = LDSCTL_OFF + 320;
constexpr int MOE_TAB_OFF = RING_BYTES + 1024, MOE_CNT_OFF = MOE_TAB_OFF + 512;
constexpr int LDS_BYTES = 147456;

#define GAS __attribute__((address_space(1)))
#define LAS __attribute__((address_space(3)))
typedef unsigned short bf16;
typedef unsigned v4u __attribute__((ext_vector_type(4)));
typedef unsigned v2u __attribute__((ext_vector_type(2)));
typedef float f32x4 __attribute__((ext_vector_type(4)));
typedef GAS unsigned gu32;
#define RLX_AGENT __ATOMIC_RELAXED, __HIP_MEMORY_SCOPE_AGENT
#define LDS_WAIT() asm volatile("s_waitcnt lgkmcnt(0)" ::: "memory")
#define VM_WAIT() asm volatile("s_waitcnt vmcnt(0)" ::: "memory")
__device__ __forceinline__ unsigned f2bf(float f) { unsigned u = __builtin_bit_cast(unsigned, f); return (u + 0x7fffu + ((u >> 16) & 1u)) >> 16; }
__device__ __forceinline__ unsigned pk2(float lo, float hi) { return f2bf(lo) | (f2bf(hi) << 16); }
__device__ __forceinline__ float bflo(unsigned w) { return __builtin_bit_cast(float, w << 16); }
__device__ __forceinline__ float bfhi(unsigned w) { return __builtin_bit_cast(float, w & 0xffff0000u); }
__device__ __forceinline__ float bf2f(bf16 b) { return __builtin_bit_cast(float, (unsigned)b << 16); }
__device__ __forceinline__ float wave_sum(float v) {
#pragma unroll
    for (int o = 1; o < 64; o <<= 1) v += __shfl_xor(v, o);
    return v;
}
__device__ __forceinline__ float wave_max(float v) {
#pragma unroll
    for (int o = 1; o < 64; o <<= 1) v = fmaxf(v, __shfl_xor(v, o));
    return v;
}
__device__ __forceinline__ float sigmoidf_(float x) { return 1.f / (1.f + __expf(-x)); }

#define XB_TMO      128
#define XB_XCNT(j)  (256  + 64 * (j))
#define XB_XSUB(j)  (1280 + 64 * (j))
#define XB_XGEN(j)  (2304 + 64 * (j))
#define XB_TOP      3328
#define XB_TOPGEN   3392
#define XCD_BAR_WORDS 3456
#define XB_SPIN_CAP (1u << 18)

__device__ __forceinline__ unsigned xb_ld(unsigned* p)              { return __hip_atomic_load(p, __ATOMIC_RELAXED, __HIP_MEMORY_SCOPE_AGENT); }
__device__ __forceinline__ unsigned xb_add(unsigned* p, unsigned v) { return __hip_atomic_fetch_add(p, v, __ATOMIC_RELAXED, __HIP_MEMORY_SCOPE_AGENT); }
__device__ __forceinline__ unsigned xb_xcc_id() { return (unsigned)__builtin_amdgcn_s_getreg((3 << 11) | 20) & 0xFu; }
#define XB_SPIN(cond, bar) do { unsigned _sp = 0; while (cond) { __builtin_amdgcn_s_sleep(1); \
    if ((++_sp & 255u) == 0u) { if (xb_ld(&(bar)[XB_TMO])) break; if (_sp > XB_SPIN_CAP) { atomicAdd(&(bar)[XB_TMO], 1u); break; } } } } while (0)

struct XcdBarrier {
    unsigned* bar; unsigned x;
    volatile LAS unsigned* st;
};

__device__ __forceinline__ XcdBarrier xcd_barrier_post(unsigned* bar, volatile LAS unsigned* st) {
    XcdBarrier b; b.bar = bar; b.x = xb_xcc_id(); b.st = st;
    if (threadIdx.x == 0) (void)xb_add(&bar[XB_XCNT(b.x)], 1u);
    return b;
}
__device__ __forceinline__ void xcd_barrier_complete(unsigned* bar, unsigned x, unsigned& nloc, unsigned& nx) {
    const unsigned G = gridDim.x * gridDim.y * gridDim.z;
    unsigned sum, cnt, mine, sp = 0u;
    for (;;) {
        sum = 0u; cnt = 0u; mine = 0u;
#pragma unroll
        for (unsigned j = 0; j < 16; ++j) { const unsigned c = xb_ld(&bar[XB_XCNT(j)]); sum += c; cnt += (c > 0u) ? 1u : 0u; mine = (j == x) ? c : mine; }
        if (sum == G) break;
        __builtin_amdgcn_s_sleep(1);
        if ((++sp & 255u) == 0u) { if (xb_ld(&bar[XB_TMO])) break; if (sp > XB_SPIN_CAP) { atomicAdd(&bar[XB_TMO], 1u); break; } }
    }
    nloc = mine > 0u ? mine : 1u; nx = cnt > 0u ? cnt : 1u;
}

__device__ __forceinline__ void xcd_barrier(const XcdBarrier& b) {
    asm volatile("s_waitcnt vmcnt(0)" ::: "memory");
    __syncthreads();
    if (threadIdx.x == 0) {
        unsigned* bar = b.bar;
        __builtin_amdgcn_s_waitcnt(0);
        unsigned nloc = b.st[0], nx = b.st[1];
        if (nloc == 0u) { xcd_barrier_complete(bar, b.x, nloc, nx); b.st[0] = nloc; b.st[1] = nx; }
        const unsigned old = xb_add(&bar[XB_XSUB(b.x)], 1u);
        const unsigned gen = old / nloc;
        if (old + 1u == (gen + 1u) * nloc) {
            __builtin_amdgcn_fence(__ATOMIC_RELEASE, "agent");
            asm volatile("s_waitcnt vmcnt(0)" ::: "memory");
            const unsigned og = xb_add(&bar[XB_TOP], 1u);
            const unsigned tg = og / nx;
            if (og + 1u == (tg + 1u) * nx) xb_add(&bar[XB_TOPGEN], 1u);
            else XB_SPIN(xb_ld(&bar[XB_TOPGEN]) == tg, bar);
            __builtin_amdgcn_fence(__ATOMIC_ACQUIRE, "agent");
            xb_add(&bar[XB_XGEN(b.x)], 1u);
            asm volatile("s_waitcnt vmcnt(0)" ::: "memory");
        } else {
            XB_SPIN(xb_ld(&bar[XB_XGEN(b.x)]) == gen, bar);
            __builtin_amdgcn_fence(__ATOMIC_ACQUIRE, "agent");
            asm volatile("s_waitcnt vmcnt(0)" ::: "memory");
        }
    }
    __syncthreads();
}

struct Frame {
    LAS unsigned char* lds;
    volatile LAS unsigned* MISC;
    gu32* ctl;
    int tid, lane, wave;
    int vcu, G;
    float* out; unsigned char* ws;
};
struct Args { const float* in[17]; float* out; unsigned char* ws; int ph_lo, ph_hi; };
#define WSP(type, off) ((type*)(F.ws + (off)))
enum { I_X = 0, I_POS, I_WIN, I_WBA, I_WBR, I_WOUT, I_LN1S, I_LN1B, I_WGR, I_BGR, I_WER, I_BER, I_WEG, I_WEU, I_WED, I_LN2S, I_LN2B };

__device__ __forceinline__ float logdecay(int h) { return log1pf(-exp2f(-5.f - (float)h)); }

__device__ __forceinline__ int win_src_col(int n) {
    if (n < C_VA) { int j = n & 127; if (j < 32) j = ((j & 1) << 4) + (j >> 1); return (n & ~127) + j; }
    if (n >= C_QR && n < C_VR) { int j = n & 127; j = ((j & 1) << 6) + (j >> 1); return (n & ~127) + j; }
    return n;
}
__device__ __forceinline__ void tr_item(const float* W, size_t ldw, int sc, int k0, bf16* WT, size_t ldt, int dr0, LAS float* scr, int lane) {
#pragma unroll 8
    for (int i = 0; i < 32; ++i) { const int kk = 2 * i + (lane >> 5); scr[kk * 33 + (lane & 31)] = W[(size_t)(k0 + kk) * ldw + sc]; }
    LDS_WAIT(); asm volatile("" ::: "memory");
    const int c = lane & 7;
#pragma unroll
    for (int j = 0; j < 4; ++j) { const int n = (lane >> 3) + 8 * j; const LAS float* s = scr + (8 * c) * 33 + n;
        v4u o; o.x = pk2(s[0 * 33], s[1 * 33]); o.y = pk2(s[2 * 33], s[3 * 33]); o.z = pk2(s[4 * 33], s[5 * 33]); o.w = pk2(s[6 * 33], s[7 * 33]);
        *(GAS v4u*)(WT + (size_t)(dr0 + n) * ldt + k0 + 8 * c) = o; }
    LDS_WAIT(); asm volatile("" ::: "memory");
}
__device__ __forceinline__ void p0_prologue(Frame& F, const Args& A) {
    LAS float* scr = (LAS float*)(F.lds + RING_OFF + F.wave * 16384);
    const int gw = F.vcu * NWAVES + F.wave, NGW = F.G * NWAVES;
    constexpr int I_IN = 32 * 608, I_A = 16 * 64, I_R = 32 * 64, I_O = 32 * 64, NITEMS = I_IN + I_A + I_R + I_O;
    for (int it = gw; it < NITEMS; it += NGW) {
        int r = it;
        if (r < I_IN) { const int kb = r / 608, nb = r % 608; tr_item(A.in[I_WIN], NIN, win_src_col(32 * nb + (F.lane & 31)), 64 * kb, WSP(bf16, WS_WINT), D, 32 * nb, scr, F.lane); continue; } r -= I_IN;
        if (r < I_A) { const int kb = r / 64, nb = r % 64; tr_item(A.in[I_WBA], D, 32 * nb + (F.lane & 31), 64 * kb, WSP(bf16, WS_WAT), 1024, 32 * nb, scr, F.lane); continue; } r -= I_A;
        if (r < I_R) { const int kb = r / 64, nb = r % 64; tr_item(A.in[I_WBR], D, 32 * nb + (F.lane & 31), 64 * kb, WSP(bf16, WS_WRT), 2048, 32 * nb, scr, F.lane); continue; } r -= I_R;
        { const int kb = r / 64, nb = r % 64; tr_item(A.in[I_WOUT], D, 32 * nb + (F.lane & 31), 64 * kb, WSP(bf16, WS_WOT), 2048, 32 * nb, scr, F.lane); }
    }
    const int gt = F.vcu * 512 + F.tid, NGT = F.G * 512;
    { const GAS f32x4* x4 = (const GAS f32x4*)A.in[I_X]; GAS v4u* xb = (GAS v4u*)WSP(bf16, WS_XB);
      for (int i = gt; i < T * D / 8; i += NGT) { const f32x4 a = x4[2 * i], b = x4[2 * i + 1]; v4u o; o.x = pk2(a.x, a.y); o.y = pk2(a.z, a.w); o.z = pk2(b.x, b.y); o.w = pk2(b.z, b.w); xb[i] = o; } }
    { const int* pos = (const int*)A.in[I_POS]; float* cA = WSP(float, WS_COSA); float* sA = WSP(float, WS_SINA); float* cR = WSP(float, WS_COSR); float* sR = WSP(float, WS_SINR);
      for (int i = gt; i < T * 80; i += NGT) { const int t = i / 80, j = i % 80;
        const double inv = (j < 16) ? exp(-((double)(2 * j) / 32.0) * 13.122363377404328)   : exp(-((double)(j - 16) / 63.0) * 9.210340371976184)  ;
        const double a = (double)pos[t] * inv, n = rint(a * 0.15915494309189535), r = a - n * 6.283185307179586;
        const float c = cosf((float)r), s = sinf((float)r);
        if (j < 16) { cA[t * 16 + j] = c; sA[t * 16 + j] = s; } else { cR[t * 64 + j - 16] = c; sR[t * 64 + j - 16] = s; } } }
}
#define EPI_LOOP_BEGIN const int row0 = u.pm * 256 + wr * 64 + fr; const int colw = wc * 32 + 8 * fq; \
    _Pragma("unroll") for (int ai = 0; ai < 2; ++ai) _Pragma("unroll") for (int m = 0; m < 4; ++m) { const int row = row0 + ai * 128 + m * 16; \
    _Pragma("unroll") for (int bj = 0; bj < 2; ++bj) { f32x4 v0 = acc[ai][bj][m][0], v1 = acc[ai][bj][m][1]; const int col = u.pn * 256 + bj * 128 + colw;
#define EPI_LOOP_END } }
__device__ __forceinline__ v4u pack8(const f32x4& v0, const f32x4& v1) { v4u w; w.x = pg8::cvt_pk_bf16(v0[0], v0[1]); w.y = pg8::cvt_pk_bf16(v0[2], v0[3]); w.z = pg8::cvt_pk_bf16(v1[0], v1[1]); w.w = pg8::cvt_pk_bf16(v1[2], v1[3]); return w; }
__device__ __forceinline__ void unpack8(const v4u w, f32x4& a, f32x4& b) { a = (f32x4){bflo(w.x), bfhi(w.x), bflo(w.y), bfhi(w.y)}; b = (f32x4){bflo(w.z), bfhi(w.z), bflo(w.w), bfhi(w.w)}; }
__device__ __forceinline__ void rot8(f32x4& v0, f32x4& v1, const f32x4 c, const f32x4 s) {
    float a, b;
    a = v0[0]; b = v0[1]; v0[0] = a * c[0] - b * s[0]; v0[1] = b * c[0] + a * s[0];
    a = v0[2]; b = v0[3]; v0[2] = a * c[1] - b * s[1]; v0[3] = b * c[1] + a * s[1];
    a = v1[0]; b = v1[1]; v1[0] = a * c[2] - b * s[2]; v1[1] = b * c[2] + a * s[2];
    a = v1[2]; b = v1[3]; v1[2] = a * c[3] - b * s[3]; v1[3] = b * c[3] + a * s[3];
}
struct EpiProj {
    bf16* O; const float *cosA, *sinA, *cosR, *sinR;
    __device__ __forceinline__ void operator()(const f32x4 (&acc)[2][2][4][2], const pg8::Unit& u, int wr, int wc, int fr, int fq) const {
        const int colt = u.pn * 256;
        int kind = 0;
        if (colt < C_VA) kind = 1; else if (colt < C_QR) kind = 0; else if (colt < C_KR) kind = 2; else if (colt < C_VR) kind = 3; else if (colt < C_GR) kind = 0; else if (colt < C_GA) kind = 4; else kind = 5;
        EPI_LOOP_BEGIN
            if (kind == 1) { if (wc == 0) { const f32x4 c = *(const f32x4*)(cosA + (size_t)row * 16 + 4 * fq), s = *(const f32x4*)(sinA + (size_t)row * 16 + 4 * fq); rot8(v0, v1, c, s); } }
            else if (kind == 2 || kind == 3) { const int i0 = wc * 16 + 4 * fq; const f32x4 c = *(const f32x4*)(cosR + (size_t)row * 64 + i0), s = *(const f32x4*)(sinR + (size_t)row * 64 + i0); rot8(v0, v1, c, s);
                if (kind == 3) { v0 = v0 * QK_SCALE; v1 = v1 * QK_SCALE; } }
            else if (kind == 4) {
#pragma unroll
                for (int j = 0; j < 4; ++j) { v0[j] = v0[j] * sigmoidf_(v0[j]); v1[j] = v1[j] * sigmoidf_(v1[j]); } }
            else if (kind == 5) {
#pragma unroll
                for (int j = 0; j < 4; ++j) { v0[j] = sigmoidf_(v0[j]); v1[j] = sigmoidf_(v1[j]); } }
            *(v4u*)(O + (size_t)row * NIN + col) = pack8(v0, v1);
        EPI_LOOP_END
    }
};
struct EpiTmp {
    float* tmp; const bf16* proj;
    __device__ __forceinline__ void operator()(const f32x4 (&acc)[2][2][4][2], const pg8::Unit& u, int wr, int wc, int fr, int fq) const {
        EPI_LOOP_BEGIN
            f32x4 g0, g1; unpack8(*(const v4u*)(proj + (size_t)row * NIN + C_GA + col), g0, g1);
            *(f32x4*)(tmp + (size_t)row * D + col) = v0 * g0; *(f32x4*)(tmp + (size_t)row * D + col + 4) = v1 * g1;
        EPI_LOOP_END
    }
};
struct EpiMerged {
    const float* tmp; const bf16* proj; bf16* merged;
    __device__ __forceinline__ void operator()(const f32x4 (&acc)[2][2][4][2], const pg8::Unit& u, int wr, int wc, int fr, int fq) const {
        EPI_LOOP_BEGIN
            f32x4 g0, g1; unpack8(*(const v4u*)(proj + (size_t)row * NIN + C_GB + col), g0, g1);
            const f32x4 t0 = *(const f32x4*)(tmp + (size_t)row * D + col), t1 = *(const f32x4*)(tmp + (size_t)row * D + col + 4);
            v0 = t0 + v0 * g0; v1 = t1 + v1 * g1;
            *(v4u*)(merged + (size_t)row * D + col) = pack8(v0, v1);
        EPI_LOOP_END
    }
};
struct EpiR1 {
    const float* x; float* r1;
    __device__ __forceinline__ void operator()(const f32x4 (&acc)[2][2][4][2], const pg8::Unit& u, int wr, int wc, int fr, int fq) const {
        EPI_LOOP_BEGIN
            const f32x4 x0 = *(const f32x4*)(x + (size_t)row * D + col), x1 = *(const f32x4*)(x + (size_t)row * D + col + 4);
            *(f32x4*)(r1 + (size_t)row * D + col) = x0 * ALPHA + v0; *(f32x4*)(r1 + (size_t)row * D + col + 4) = x1 * ALPHA + v1;
        EPI_LOOP_END
    }
};
__device__ __forceinline__ float dot128(const bf16* a, const bf16* b) {
    float s = 0.f;
#pragma unroll
    for (int x = 0; x < 16; ++x) { const v4u qa = *(const GAS v4u*)(a + 8 * x), kb = *(const GAS v4u*)(b + 8 * x);
        s += bflo(qa.x) * bflo(kb.x) + bfhi(qa.x) * bfhi(kb.x) + bflo(qa.y) * bflo(kb.y) + bfhi(qa.y) * bfhi(kb.y) + bflo(qa.z) * bflo(kb.z) + bfhi(qa.z) * bfhi(kb.z) + bflo(qa.w) * bflo(kb.w) + bfhi(qa.w) * bfhi(kb.w); }
    return s;
}
__device__ __forceinline__ void p2_attn_ref(Frame& F, const Args& A) {
    const bf16* proj = WSP(bf16, WS_PROJ); bf16* oag = WSP(bf16, WS_OAG); float* lse = WSP(float, WS_LSE);
    const int gw = F.vcu * NWAVES + F.wave, NGW = F.G * NWAVES, lane = F.lane;
    for (int it = gw; it < 3 * 8 * T; it += NGW) {
        const int g = it / (8 * T), rem = it % (8 * T), t = rem >> 3, h = rem & 7;
        const int d = (g == 0) ? 1 : (g == 1 ? 4 : 16);
        const int m = t / d, nk = (m < 128 ? m : 128) + 1;
        const size_t hc = (size_t)(g * 8 + h) * 128;
        const bf16* q = proj + (size_t)t * NIN + C_QA + hc;
        float sc[3];
#pragma unroll
        for (int j = 0; j < 3; ++j) { const int s = lane + 64 * j; float a = -__builtin_inff();
            if (s < nk) a = dot128(q, proj + (size_t)(t - s * d) * NIN + C_KA + hc) * QK_SCALE;
            sc[j] = a; }
        const float mx = wave_max(fmaxf(sc[0], fmaxf(sc[1], sc[2])));
        float p[3];
#pragma unroll
        for (int j = 0; j < 3; ++j) p[j] = (lane + 64 * j < nk) ? __expf(sc[j] - mx) : 0.f;
        const float sum = wave_sum(p[0] + p[1] + p[2]);
        float o0 = 0.f, o1 = 0.f;
        for (int s = 0; s < nk; ++s) { const float pj = (s < 64) ? p[0] : (s < 128 ? p[1] : p[2]); const float pv = __shfl(pj, s & 63);
            const unsigned vv = *(const GAS unsigned*)(proj + (size_t)(t - s * d) * NIN + C_VA + hc + 2 * lane); o0 += pv * bflo(vv); o1 += pv * bfhi(vv); }
        const float rs = 1.f / sum;
        *(GAS unsigned*)(oag + ((size_t)g * T + t) * 1024 + h * 128 + 2 * lane) = pk2(o0 * rs, o1 * rs);
        if (lane == 0) lse[((size_t)g * T + t) * 8 + h] = mx + __logf(sum);
    }
}
__device__ __forceinline__ void p2_kv_ref(Frame& F, const Args& A) {
    const bf16* proj = WSP(bf16, WS_PROJ); bf16* kvT = WSP(bf16, WS_KV);
    const int gt = F.vcu * 512 + F.tid, NGT = F.G * 512;
    for (int idx = gt; idx < 64 * 8 * 256 * 128; idx += NGT) {
        const int d = idx & 127, e = (idx >> 7) & 255, h = (idx >> 15) & 7, c = idx >> 18;
        const float ld = logdecay(h); float acc = 0.f;
        for (int m = 0; m < 128; ++m) { const size_t r = (size_t)(c * 128 + m) * NIN;
            acc += bf2f(proj[r + C_KR + h * 128 + d]) * __expf((float)(127 - m) * ld) * bf2f(proj[r + C_VR + h * 256 + e]); }
        kvT[idx] = (bf16)f2bf(acc);
    }
}
__device__ __forceinline__ void p3_scan_combine(Frame& F, const Args& A) {
    const int gt = F.vcu * 512 + F.tid, NGT = F.G * 512;
    { const GAS unsigned* kv = (const GAS unsigned*)WSP(bf16, WS_KV); GAS unsigned* st = (GAS unsigned*)WSP(bf16, WS_ST);
      for (int i = gt; i < 131072; i += NGT) {
        const int h = i >> 14; const float dc = __expf(128.f * logdecay(h)); float s0 = 0.f, s1 = 0.f;
#pragma unroll 8
        for (int c = 0; c < 64; ++c) { const unsigned w = kv[(size_t)c * 131072 + i]; st[(size_t)c * 131072 + i] = pk2(s0, s1); s0 = dc * s0 + bflo(w); s1 = dc * s1 + bfhi(w); } } }
    { const bf16* oag = WSP(bf16, WS_OAG); const float* lse = WSP(float, WS_LSE); bf16* oa = WSP(bf16, WS_OA);
      for (int i = gt; i < T * 128; i += NGT) {
        const int t = i >> 7, ch = i & 127, h = ch >> 4;
        const float l0 = lse[(size_t)t * 8 + h], l1 = lse[((size_t)T + t) * 8 + h], l2 = lse[((size_t)2 * T + t) * 8 + h];
        const float mx = fmaxf(l0, fmaxf(l1, l2)); const float e0 = __expf(l0 - mx), e1 = __expf(l1 - mx), e2 = __expf(l2 - mx); const float rs = 1.f / (e0 + e1 + e2);
        f32x4 a0, a1, b0, b1, c0, c1;
        unpack8(*(const GAS v4u*)(oag + (size_t)t * 1024 + ch * 8), a0, a1); unpack8(*(const GAS v4u*)(oag + ((size_t)T + t) * 1024 + ch * 8), b0, b1); unpack8(*(const GAS v4u*)(oag + ((size_t)2 * T + t) * 1024 + ch * 8), c0, c1);
        const f32x4 r0 = (a0 * e0 + b0 * e1 + c0 * e2) * rs, r1 = (a1 * e0 + b1 * e1 + c1 * e2) * rs;
        v4u o; o.x = pk2(r0[0], r0[1]); o.y = pk2(r0[2], r0[3]); o.z = pk2(r1[0], r1[1]); o.w = pk2(r1[2], r1[3]);
        *(GAS v4u*)(oa + (size_t)t * 1024 + ch * 8) = o; } }
}
__device__ __forceinline__ void p4_ret_ref(Frame& F, const Args& A) {
    const bf16* proj = WSP(bf16, WS_PROJ); const bf16* stT = WSP(bf16, WS_ST); bf16* orr = WSP(bf16, WS_OR);
    const int gw = F.vcu * NWAVES + F.wave, NGW = F.G * NWAVES, lane = F.lane;
    for (int it = gw; it < T * 8; it += NGW) {
        const int t = it >> 3, h = it & 7, n = t & 127, c = t >> 7; const float ld = logdecay(h);
        const bf16* q = proj + (size_t)t * NIN + C_QR + h * 128;
        float sc[2];
#pragma unroll
        for (int j = 0; j < 2; ++j) { const int m = lane + 64 * j; float a = 0.f;
            if (m <= n) a = dot128(q, proj + (size_t)(c * 128 + m) * NIN + C_KR + h * 128) * __expf((float)(n - m) * ld);
            sc[j] = a; }
        float o[4] = {0.f, 0.f, 0.f, 0.f};
        for (int m = 0; m <= n; ++m) { const float pv = __shfl((m < 64) ? sc[0] : sc[1], m & 63); const bf16* v = proj + (size_t)(c * 128 + m) * NIN + C_VR + h * 256;
#pragma unroll
            for (int j = 0; j < 4; ++j) o[j] += pv * bf2f(v[lane + 64 * j]); }
        const float qd = __expf((float)(n + 1) * ld);
#pragma unroll
        for (int j = 0; j < 4; ++j) { const int e = lane + 64 * j; o[j] += qd * dot128(q, stT + ((size_t)(c * 8 + h) * 256 + e) * 128); }
        const float mean = wave_sum(o[0] + o[1] + o[2] + o[3]) * (1.f / 256.f);
        float q2 = 0.f;
#pragma unroll
        for (int j = 0; j < 4; ++j) { o[j] -= mean; q2 += o[j] * o[j]; }
        const float rstd = 1.f / sqrtf(wave_sum(q2) * (1.f / 256.f) + LN_EPS);
#pragma unroll
        for (int j = 0; j < 4; ++j) { const int e = lane + 64 * j; orr[(size_t)t * D + h * 256 + e] = (bf16)f2bf(bf2f(proj[(size_t)t * NIN + C_GR + h * 256 + e]) * o[j] * rstd); }
    }
}
__device__ __forceinline__ void p7_ln_router(Frame& F, const Args& A) {
    const int gw = F.vcu * NWAVES + F.wave, NGW = F.G * NWAVES, lane = F.lane;
    float* x1 = F.out; bf16* x1b = WSP(bf16, WS_X1B); float* asgw = WSP(float, WS_ASGW); int* asge = WSP(int, WS_ASGE); int* list = WSP(int, WS_LIST);
    LAS float* xs = (LAS float*)(F.lds + RING_OFF + F.wave * 16384);
    for (int t = gw; t < T; t += NGW) {
        { const GAS f32x4* sc4 = (const GAS f32x4*)A.in[I_LN1S]; const GAS f32x4* bi4 = (const GAS f32x4*)A.in[I_LN1B];
          GAS f32x4* xr = (GAS f32x4*)(x1 + (size_t)t * D) + lane;
          f32x4 v[8]; float s = 0.f;
#pragma unroll
          for (int j = 0; j < 8; ++j) { v[j] = xr[64 * j]; s += (v[j].x + v[j].y) + (v[j].z + v[j].w); }
          const float mean = wave_sum(s) * (1.f / D); float s2 = 0.f;
#pragma unroll
          for (int j = 0; j < 8; ++j) { v[j] = v[j] - mean; s2 += (v[j].x * v[j].x + v[j].y * v[j].y) + (v[j].z * v[j].z + v[j].w * v[j].w); }
          const float rstd = 1.f / sqrtf(wave_sum(s2) * (1.f / D) + LN_EPS);
          GAS v2u* o8 = (GAS v2u*)(x1b + (size_t)t * D) + lane;
#pragma unroll
          for (int j = 0; j < 8; ++j) { v[j] = v[j] * rstd * sc4[lane + 64 * j] + bi4[lane + 64 * j]; xr[64 * j] = v[j];
              v2u w; w.x = pk2(v[j].x, v[j].y); w.y = pk2(v[j].z, v[j].w); o8[64 * j] = w; *(LAS f32x4*)(xs + 4 * (lane + 64 * j)) = v[j]; } }
        LDS_WAIT(); asm volatile("" ::: "memory");
        float gl[4] = {0.f, 0.f, 0.f, 0.f};
        { const GAS f32x4* wg4 = (const GAS f32x4*)A.in[I_WGR];
#pragma unroll 4
          for (int i = 0; i < 32; ++i) { const int dd = lane + 64 * i; const f32x4 wv = wg4[dd]; const float xv = xs[dd]; gl[0] += xv * wv.x; gl[1] += xv * wv.y; gl[2] += xv * wv.z; gl[3] += xv * wv.w; } }
        const float* bg = A.in[I_BGR];
#pragma unroll
        for (int q = 0; q < 4; ++q) gl[q] = wave_sum(gl[q]) + bg[q];
        int gs = 0; float gm = gl[0];
#pragma unroll
        for (int q = 1; q < 4; ++q) if (gl[q] > gm) { gm = gl[q]; gs = q; }
        const float pg = 1.f / (__expf(gl[0] - gm) + __expf(gl[1] - gm) + __expf(gl[2] - gm) + __expf(gl[3] - gm));
        float el[8] = {0.f, 0.f, 0.f, 0.f, 0.f, 0.f, 0.f, 0.f};
        { const GAS f32x4* we4 = (const GAS f32x4*)(A.in[I_WER] + (size_t)gs * D * 8);
#pragma unroll 4
          for (int i = 0; i < 32; ++i) { const int dd = lane + 64 * i; const f32x4 w0 = we4[dd * 2], w1 = we4[dd * 2 + 1]; const float xv = xs[dd];
              el[0] += xv * w0.x; el[1] += xv * w0.y; el[2] += xv * w0.z; el[3] += xv * w0.w; el[4] += xv * w1.x; el[5] += xv * w1.y; el[6] += xv * w1.z; el[7] += xv * w1.w; } }
        const float* be = A.in[I_BER];
#pragma unroll
        for (int q = 0; q < 8; ++q) el[q] = wave_sum(el[q]) + be[gs * 8 + q];
        int i1 = 0; float v1 = el[0];
#pragma unroll
        for (int q = 1; q < 8; ++q) if (el[q] > v1) { v1 = el[q]; i1 = q; }
        int i2 = -1; float v2 = -__builtin_inff();
#pragma unroll
        for (int q = 0; q < 8; ++q) if (q != i1 && el[q] > v2) { v2 = el[q]; i2 = q; }
        const float e2 = __expf(v2 - v1); const float w1 = pg / (1.f + e2), w2 = pg * e2 / (1.f + e2);
        if (lane < 2) { const int ex = gs * 8 + (lane == 0 ? i1 : i2); const int a = t * 2 + lane;
            const unsigned pos = __hip_atomic_fetch_add((unsigned*)(F.ctl + CW_CNT + 64 * ex), 1u, RLX_AGENT);
            list[ex * LCAP + pos] = a; asgw[a] = (lane == 0) ? w1 : w2; asge[a] = ex; }
        LDS_WAIT(); asm volatile("" ::: "memory");
    }
}
__device__ __forceinline__ void p7_expert_weights(Frame& F, const Args& A) {
    LAS float* scr = (LAS float*)(F.lds + RING_OFF + F.wave * 16384);
    const int gw = F.vcu * NWAVES + F.wave, NGW = F.G * NWAVES;
    for (int it = gw; it < NEXP * 1536; it += NGW) {
        const int e = it / 1536; int r = it % 1536;
        if (r < 1024) { const int up = r >> 9; r &= 511; const int kb = r >> 4, nb = r & 15, n0 = 32 * nb;
            tr_item(A.in[up ? I_WEU : I_WEG] + (size_t)e * D * EHID, EHID, n0 + (F.lane & 31), 64 * kb, WSP(bf16, WS_WGU) + (size_t)e * 1024 * D, D, 256 * (n0 >> 7) + 128 * up + (n0 & 127), scr, F.lane); }
        else { r -= 1024; const int kb = r >> 6, nb = r & 63;
            tr_item(A.in[I_WED] + (size_t)e * EHID * D, D, 32 * nb + (F.lane & 31), 64 * kb, WSP(bf16, WS_WD) + (size_t)e * D * EHID, EHID, 32 * nb, scr, F.lane); }
    }
}
__device__ __forceinline__ float dotn(const bf16* a, const bf16* b, int n8) {
    float s = 0.f;
    for (int x = 0; x < n8; ++x) { const v4u qa = *(const GAS v4u*)(a + 8 * x), kb = *(const GAS v4u*)(b + 8 * x);
        s += bflo(qa.x) * bflo(kb.x) + bfhi(qa.x) * bfhi(kb.x) + bflo(qa.y) * bflo(kb.y) + bfhi(qa.y) * bfhi(kb.y) + bflo(qa.z) * bflo(kb.z) + bfhi(qa.z) * bfhi(kb.z) + bflo(qa.w) * bflo(kb.w) + bfhi(qa.w) * bfhi(kb.w); }
    return s;
}
__device__ __forceinline__ void p8_moe_ref(Frame& F, const Args& A) {
    const bf16* x1b = WSP(bf16, WS_X1B); const bf16* wgu = WSP(bf16, WS_WGU); const bf16* wd = WSP(bf16, WS_WD); const float* asgw = WSP(float, WS_ASGW); const int* asge = WSP(int, WS_ASGE);
    bf16* hidg = WSP(bf16, WS_HID); bf16* yb = WSP(bf16, WS_YBUF);
    const int gw = F.vcu * NWAVES + F.wave, NGW = F.G * NWAVES, lane = F.lane;
    for (int a = gw; a < 2 * T; a += NGW) {
        const int t = a >> 1, e = asge[a]; const float w = asgw[a];
        const bf16* xr = x1b + (size_t)t * D; const bf16* wg = wgu + (size_t)e * 1024 * D; bf16* hrow = hidg + (size_t)a * EHID;
#pragma unroll 1
        for (int i = 0; i < 8; ++i) { const int j = lane + 64 * i; const bf16* gr = wg + (size_t)(256 * (j >> 7) + (j & 127)) * D;
            const float gv = dotn(xr, gr, 256), uv = dotn(xr, gr + (size_t)128 * D, 256); hrow[j] = (bf16)f2bf(gv * sigmoidf_(gv) * uv); }
        VM_WAIT(); __builtin_amdgcn_fence(__ATOMIC_RELEASE, "workgroup"); __builtin_amdgcn_fence(__ATOMIC_ACQUIRE, "agent");
        const bf16* wdr = wd + (size_t)e * D * EHID;
#pragma unroll 1
        for (int i = 0; i < 32; ++i) { const int col = lane + 64 * i; yb[(size_t)a * D + col] = (bf16)f2bf(w * dotn(hrow, wdr + (size_t)col * EHID, 64)); }
    }
}
__device__ __forceinline__ void p10_final(Frame& F, const Args& A) {
    const int gw = F.vcu * NWAVES + F.wave, NGW = F.G * NWAVES, lane = F.lane;
    const bf16* yb = WSP(bf16, WS_YBUF);
    const GAS f32x4* sc4 = (const GAS f32x4*)A.in[I_LN2S]; const GAS f32x4* bi4 = (const GAS f32x4*)A.in[I_LN2B];
    for (int t = gw; t < T; t += NGW) {
        GAS f32x4* xr = (GAS f32x4*)(F.out + (size_t)t * D) + lane;
        const GAS v2u* y0 = (const GAS v2u*)(yb + (size_t)(2 * t) * D) + lane; const GAS v2u* y1 = (const GAS v2u*)(yb + (size_t)(2 * t + 1) * D) + lane;
        f32x4 v[8]; float s = 0.f;
#pragma unroll
        for (int j = 0; j < 8; ++j) { const f32x4 xv = xr[64 * j]; const v2u a = y0[64 * j], b = y1[64 * j];
            v[j] = xv * ALPHA + (f32x4){bflo(a.x) + bflo(b.x), bfhi(a.x) + bfhi(b.x), bflo(a.y) + bflo(b.y), bfhi(a.y) + bfhi(b.y)};
            s += (v[j].x + v[j].y) + (v[j].z + v[j].w); }
        const float mean = wave_sum(s) * (1.f / D); float s2 = 0.f;
#pragma unroll
        for (int j = 0; j < 8; ++j) { v[j] = v[j] - mean; s2 += (v[j].x * v[j].x + v[j].y * v[j].y) + (v[j].z * v[j].z + v[j].w * v[j].w); }
        const float rstd = 1.f / sqrtf(wave_sum(s2) * (1.f / D) + LN_EPS);
#pragma unroll
        for (int j = 0; j < 8; ++j) xr[64 * j] = v[j] * rstd * sc4[lane + 64 * j] + bi4[lane + 64 * j];
    }
}
struct MoeOrder {
    const LAS int* tab; const LAS int* cnt; const int* list; int nRT, nN, G, c;
    __device__ __forceinline__ bool next(int i, pg8::Unit& u) const {
        const int L = i * G + c; if (L >= nRT * nN) return false;
        const int rt = L / nN; u.pm = rt; u.pn = L - rt * nN; const int tv = tab[rt]; u.e = tv & 255; u.lt = tv >> 8; return true;
    }
    __device__ __forceinline__ void a_rows(const pg8::Unit& u, unsigned (&v)[2][2], const int (&RA)[2], const int (&CA)[2], int K) const {
        const int n = cnt[u.e];
#pragma unroll
        for (int h = 0; h < 2; ++h)
#pragma unroll
            for (int i = 0; i < 2; ++i) { const int idx = u.lt * 256 + h * 128 + RA[i]; const int tok = (idx < n) ? (list[u.e * LCAP + idx] >> 1) : 0; v[h][i] = (unsigned)(tok * K + CA[i]) * 2u; }
    }
};
__device__ __forceinline__ int moe_tables(Frame& F) {
    LAS int* tab = (LAS int*)(F.lds + MOE_TAB_OFF); LAS int* cnt = (LAS int*)(F.lds + MOE_CNT_OFF);
    if (F.tid < NEXP) cnt[F.tid] = (int)__hip_atomic_load((unsigned*)(F.ctl + CW_CNT + 64 * F.tid), RLX_AGENT);
    __syncthreads();
    if (F.tid == 0) { int rt = 0; for (int e = 0; e < NEXP; ++e) { const int nt = (cnt[e] + 255) >> 8; for (int lt = 0; lt < nt; ++lt) tab[rt++] = e | (lt << 8); } tab[127] = rt; }
    __syncthreads();
    return tab[127];
}
struct EpiHid {
    bf16* hid;
    __device__ __forceinline__ void operator()(const f32x4 (&acc)[2][2][4][2], const pg8::Unit& u, int wr, int wc, int fr, int fq) const {
        const int row0 = u.pm * 256 + wr * 64 + fr, col = u.pn * 128 + wc * 32 + 8 * fq;
#pragma unroll
        for (int ai = 0; ai < 2; ++ai)
#pragma unroll
            for (int m = 0; m < 4; ++m) { const int row = row0 + ai * 128 + m * 16; f32x4 h0, h1;
#pragma unroll
                for (int j = 0; j < 4; ++j) { const float g0 = acc[ai][0][m][0][j], g1 = acc[ai][0][m][1][j]; h0[j] = g0 * sigmoidf_(g0) * acc[ai][1][m][0][j]; h1[j] = g1 * sigmoidf_(g1) * acc[ai][1][m][1][j]; }
                *(v4u*)(hid + (size_t)row * EHID + col) = pack8(h0, h1); }
    }
};
struct EpiY {
    bf16* yb; const int* list; const float* asgw; const LAS int* cnt;
    __device__ __forceinline__ void operator()(const f32x4 (&acc)[2][2][4][2], const pg8::Unit& u, int wr, int wc, int fr, int fq) const {
        const int n = cnt[u.e], colw = u.pn * 256 + wc * 32 + 8 * fq;
#pragma unroll
        for (int ai = 0; ai < 2; ++ai)
#pragma unroll
            for (int m = 0; m < 4; ++m) { const int idx = u.lt * 256 + ai * 128 + wr * 64 + m * 16 + fr;
                if (idx < n) { const int a = list[u.e * LCAP + idx]; const float w = asgw[a];
#pragma unroll
                    for (int bj = 0; bj < 2; ++bj) *(v4u*)(yb + (size_t)a * D + colw + bj * 128) = pack8(acc[ai][bj][m][0] * w, acc[ai][bj][m][1] * w); } }
    }
};

constexpr int N_PHASES = 11;
__global__ void __launch_bounds__(NWAVES * 64, 2) fwd_kernel(Args args) {
    extern __shared__ __attribute__((aligned(16))) unsigned char lds[];
    Frame F;
    F.lds = (LAS unsigned char*)lds;
    F.MISC = (volatile LAS unsigned*)(F.lds + MISC_OFF);
    F.tid = threadIdx.x; F.lane = F.tid & 63; F.wave = __builtin_amdgcn_readfirstlane(F.tid >> 6);
    F.G = gridDim.x; { const int bx = blockIdx.x; F.vcu = (F.G % 8 == 0) ? (bx % 8) * (F.G / 8) + bx / 8 : bx; }
    F.ws = args.ws; F.ctl = (gu32*)(args.ws + WS_CTL); F.out = args.out;
    const Args& A = args;
    for (int u = F.tid; u < (LDS_BYTES - LDSCTL_OFF) / 4; u += NWAVES * 64) ((LAS unsigned*)(F.lds + LDSCTL_OFF))[u] = 0u;
    __syncthreads();
    XcdBarrier bar; bar.bar = (unsigned*)(F.ctl + CW_BAR); bar.x = 0; bar.st = nullptr;
    if (!MK_SPLIT) bar = xcd_barrier_post((unsigned*)(F.ctl + CW_BAR), F.MISC + 8);
    const int lo = args.ph_lo, hi = args.ph_hi;
#ifndef PH_MASK
#define PH_MASK 0xFFFF
#endif
#define IN(k) (((PH_MASK >> (k)) & 1) && lo <= (k) && (k) < hi)
#define SEAM(k) do { if (IN(k) && IN((k) + 1)) xcd_barrier(bar); } while (0)

    if (IN(0)) { p0_prologue(F, A); } SEAM(0);
    if (IN(1)) {
        pg8::Gemm g{WSP(bf16, WS_XB), WSP(bf16, WS_WINT), D, 0}; pg8::StaticOrder S; S.init(T, NIN, F.G, (int)blockIdx.x);
        EpiProj E{WSP(bf16, WS_PROJ), WSP(float, WS_COSA), WSP(float, WS_SINA), WSP(float, WS_COSR), WSP(float, WS_SINR)};
        pg8::gemm_phase<EpiProj, pg8::StaticOrder, true, false>(F.lds + RING_OFF, g, S, E);
    } SEAM(1);
    if (IN(2)) { p2_attn_ref(F, A); p2_kv_ref(F, A); } SEAM(2);
    if (IN(3)) { p3_scan_combine(F, A); } SEAM(3);
    if (IN(4)) { p4_ret_ref(F, A); } SEAM(4);
    if (IN(5)) {
        { pg8::Gemm g{WSP(bf16, WS_OA), WSP(bf16, WS_WAT), 1024, 0}; pg8::StaticOrder S; S.init(T, D, F.G, (int)blockIdx.x);
          EpiTmp E{WSP(float, WS_TMP), WSP(bf16, WS_PROJ)};
          pg8::gemm_phase<EpiTmp, pg8::StaticOrder, true, false>(F.lds + RING_OFF, g, S, E); }
        { pg8::Gemm g{WSP(bf16, WS_OR), WSP(bf16, WS_WRT), 2048, 0}; pg8::StaticOrder S; S.init(T, D, F.G, (int)blockIdx.x);
          EpiMerged E{WSP(float, WS_TMP), WSP(bf16, WS_PROJ), WSP(bf16, WS_MERGED)};
          pg8::gemm_phase<EpiMerged, pg8::StaticOrder, true, false>(F.lds + RING_OFF, g, S, E); }
    } SEAM(5);
    if (IN(6)) {
        pg8::Gemm g{WSP(bf16, WS_MERGED), WSP(bf16, WS_WOT), 2048, 0}; pg8::StaticOrder S; S.init(T, D, F.G, (int)blockIdx.x);
        EpiR1 E{A.in[I_X], F.out};
        pg8::gemm_phase<EpiR1, pg8::StaticOrder, true, false>(F.lds + RING_OFF, g, S, E);
    } SEAM(6);
    if (IN(7)) { p7_ln_router(F, A); p7_expert_weights(F, A); } SEAM(7);
    if (IN(8)) {
        const int nRT = moe_tables(F);
        pg8::Gemm g{WSP(bf16, WS_X1B), WSP(bf16, WS_WGU), 2048, (size_t)1024 * D * 2};
        MoeOrder S{(const LAS int*)(F.lds + MOE_TAB_OFF), (const LAS int*)(F.lds + MOE_CNT_OFF), WSP(int, WS_LIST), nRT, 4, F.G, (int)blockIdx.x};
        EpiHid E{WSP(bf16, WS_HID)};
        pg8::gemm_phase<EpiHid, MoeOrder, true, true>(F.lds + RING_OFF, g, S, E);
    } SEAM(8);
    if (IN(9)) {
        const int nRT = moe_tables(F);
        pg8::Gemm g{WSP(bf16, WS_HID), WSP(bf16, WS_WD), EHID, (size_t)D * EHID * 2};
        MoeOrder S{(const LAS int*)(F.lds + MOE_TAB_OFF), (const LAS int*)(F.lds + MOE_CNT_OFF), WSP(int, WS_LIST), nRT, 8, F.G, (int)blockIdx.x};
        EpiY E{WSP(bf16, WS_YBUF), WSP(int, WS_LIST), WSP(float, WS_ASGW), (const LAS int*)(F.lds + MOE_CNT_OFF)};
        pg8::gemm_phase<EpiY, MoeOrder, true, false>(F.lds + RING_OFF, g, S, E);
    } SEAM(9);
    if (IN(10)) { p10_final(F, A); }
#undef IN
#undef SEAM
}

extern "C" void kernel_launch(void* const* d_in, const int* in_sizes, int n_in, void* d_out, int out_size, void* d_ws, size_t ws_size, hipStream_t stream) {
    static int grid = 0;
    if (grid == 0) {
        if (n_in != 17 || in_sizes[0] != T * D || out_size != T * D || ws_size < WS_END) { fprintf(stderr, "kernel_launch: unexpected shapes (n_in %d, in0 %d, out %d, ws %zu < %zu); nothing launched\n", n_in, n_in > 0 ? in_sizes[0] : -1, out_size, ws_size, (size_t)WS_END); grid = -1; return; }
        int dev = 0, cus = 0, per_cu = 0;
        if (hipGetDevice(&dev) != hipSuccess || hipDeviceGetAttribute(&cus, hipDeviceAttributeMultiprocessorCount, dev) != hipSuccess) { grid = -1; return; }
        if (hipFuncSetAttribute((const void*)fwd_kernel, hipFuncAttributeMaxDynamicSharedMemorySize, LDS_BYTES) != hipSuccess) { fprintf(stderr, "kernel_launch: hipFuncSetAttribute failed\n"); grid = -1; return; }
        if (hipOccupancyMaxActiveBlocksPerMultiprocessor(&per_cu, (const void*)fwd_kernel, NWAVES * 64, LDS_BYTES) != hipSuccess || per_cu < 1)
            fprintf(stderr, "kernel_launch: note: occupancy query reports %d workgroups per CU\n", per_cu);
        (void)hipGetLastError();
        grid = cus;
    }
    if (grid < 0) return;
    if (hipMemsetAsync((char*)d_ws + WS_CTL, 0, CTL_ZERO_BYTES, stream) != hipSuccess) return;
    Args a{};
    for (int i = 0; i < 17; ++i) a.in[i] = (const float*)d_in[i];
    a.out = (float*)d_out; a.ws = (unsigned char*)d_ws;
#if MK_SPLIT
    for (int p = 0; p < N_PHASES; ++p) { a.ph_lo = p; a.ph_hi = p + 1; hipLaunchKernelGGL(fwd_kernel, dim3(grid), dim3(NWAVES * 64), LDS_BYTES, stream, a); }
#else
    a.ph_lo = 0; a.ph_hi = N_PHASES;
    hipLaunchKernelGGL(fwd_kernel, dim3(grid), dim3(NWAVES * 64), LDS_BYTES, stream, a);
#endif
    const hipError_t le = hipPeekAtLastError();
    if (le != hipSuccess) fprintf(stderr, "kernel_launch: launch failed: %s\n", hipGetErrorName(le));
}
```

```cpp
#include <hip/hip_runtime.h>
#include <cstdio>
#include <cstdint>
#ifndef MK_SPLIT
#define MK_SPLIT 0
#endif
namespace pg8 {
#define PG8_LAS __attribute__((address_space(3)))
typedef unsigned short bf16_t;
typedef short bf16x8 __attribute__((ext_vector_type(8)));
typedef float f32x4 __attribute__((ext_vector_type(4)));
typedef unsigned u32x4 __attribute__((ext_vector_type(4)));
constexpr int BM = 256, BK = 64, HALF = 128, HTB = HALF * BK * 2  , STAGE_BYTES = 8 * HTB, NXCD = 8, WGM = 8;

__host__ __device__ __forceinline__ int lds_byte(int r, int c) { const int st = (r >> 4) * 2 + (c >> 5), rr = r & 15, cc = c & 31, ob = rr * 64 + cc * 2; return st * 1024 + (ob ^ (((ob >> 9) & 1) << 5)); }
__host__ __device__ __forceinline__ void stage_rc(int b, int& R, int& C) { const int st = b / 1024, sb = b % 1024, swz = sb ^ (((sb >> 9) & 1) << 5); R = (st >> 1) * 16 + swz / 64; C = (st & 1) * 32 + (swz % 64) / 2; }
__host__ __device__ __forceinline__ int perm32(int rho) { const int n = rho >> 4, i = rho & 15; return 8 * (i >> 2) + 4 * n + (i & 3); }

struct Unit { int pm, pn, e, lt; };
struct Gemm { const bf16_t* A; const bf16_t* Bt; int K; size_t bstride; };

struct StaticOrder {
    int nM, nN, nwg, G, c;
    __host__ __device__ void init(int M, int N, int G_, int c_) { nM = M / BM; nN = N / BM; nwg = nM * nN; G = G_; c = c_; }
    __host__ __device__ bool next(int i, Unit& u) const {
        const long L = (long)i * G + c; if (L >= nwg) return false;
        int wgid = (int)L; { const int q = nwg / NXCD, r = nwg % NXCD, xcd = wgid % NXCD, off = wgid / NXCD; wgid = (xcd < r ? xcd * (q + 1) : r * (q + 1) + (xcd - r) * q) + off; }
        const int nig = WGM * nN, gid = wgid / nig, fm = gid * WGM, gsz = (nM - fm) < WGM ? (nM - fm) : WGM;
        u.pm = fm + ((wgid % nig) % gsz); u.pn = (wgid % nig) / gsz; u.e = 0; u.lt = 0; return true;
    }
    __device__ __forceinline__ void a_rows(const Unit&, unsigned (&)[2][2], const int (&)[2], const int (&)[2], int) const {}
};
__device__ __forceinline__ unsigned cvt_pk_bf16(float lo, float hi) { unsigned r; asm volatile("v_cvt_pk_bf16_f32 %0, %1, %2" : "=v"(r) : "v"(lo), "v"(hi)); return r; }

template <class Epi, class Sched, bool ALIGN_EPI, bool GATHER>
__device__ __forceinline__ void gemm_phase(PG8_LAS unsigned char* lds, const Gemm g, const Sched& S, const Epi& E) {
    const int tid = threadIdx.x, wid = __builtin_amdgcn_readfirstlane(tid >> 6), lane = tid & 63, wr = wid >> 2, wc = wid & 3, fr = lane & 15, fq = lane >> 4;
    const int K = g.K, nt = K / BK;
    const size_t kstep = (size_t)(BK * 2);
    const size_t hstep = (size_t)HALF * K * 2;
    const size_t tstep = 2 * hstep;
    unsigned voffB[2], vA[2][2], vAn[2][2]; int RA[2], CA[2];
#pragma unroll
    for (int i = 0; i < 2; ++i) { int R, C; stage_rc(tid * 16 + i * 8192, R, C); const int Rb = (R & ~31) + perm32(R & 31);
        RA[i] = R; CA[i] = C; voffB[i] = (unsigned)(Rb * K + C) * 2u;
        vA[0][i] = (unsigned)(R * K + C) * 2u; vA[1][i] = vA[0][i] + (unsigned)hstep; vAn[0][i] = vA[0][i]; vAn[1][i] = vA[1][i]; }
    const unsigned ldsw = (unsigned)wid * 1024u;
    const int aoff = lds_byte(wr * 64 + fr, fq * 8), boff = lds_byte(wc * 32 + fr, fq * 8);
#define PG8_SA(b, h) (((b) * 2 + (h)) * HTB)
#define PG8_SB(b, h) ((4 + (b) * 2 + (h)) * HTB)
#define PG8_STAGE(bufoff, gbase, voff) do { _Pragma("unroll") for (int _i = 0; _i < 2; ++_i) \
        __builtin_amdgcn_global_load_lds((const unsigned*)((const char*)(gbase) + (voff)[_i]), (PG8_LAS unsigned*)(lds + (bufoff) + ldsw + _i * 8192), 16, 0, 0); } while (0)
#define PG8_LDA(dst, b, h) do { _Pragma("unroll") for (int m = 0; m < 4; ++m) _Pragma("unroll") for (int k = 0; k < 2; ++k) dst[m][k] = *(const PG8_LAS bf16x8*)(lds + PG8_SA(b, h) + aoff + m * 2048 + k * 1024); } while (0)
#define PG8_LDB(dst, b, h) do { _Pragma("unroll") for (int n = 0; n < 2; ++n) _Pragma("unroll") for (int k = 0; k < 2; ++k) dst[n][k] = *(const PG8_LAS bf16x8*)(lds + PG8_SB(b, h) + boff + n * 2048 + k * 1024); } while (0)
#define PG8_MMA(ai, bj, At, Bt) do { __builtin_amdgcn_s_setprio(1); _Pragma("unroll") for (int m = 0; m < 4; ++m) _Pragma("unroll") for (int n = 0; n < 2; ++n) _Pragma("unroll") for (int k = 0; k < 2; ++k) \
        acc[ai][bj][m][n] = __builtin_amdgcn_mfma_f32_16x16x32_bf16(Bt[n][k], At[m][k], acc[ai][bj][m][n], 0, 0, 0); __builtin_amdgcn_s_setprio(0); } while (0)
#define PG8_WAIT_V(n) asm volatile("s_waitcnt vmcnt(" #n ")" ::: "memory")
#define PG8_WAIT_L(n) asm volatile("s_waitcnt lgkmcnt(" #n ")" ::: "memory")
#define PG8_BAR __builtin_amdgcn_s_barrier()
#define PG8_SCHED __builtin_amdgcn_sched_barrier(0)
    Unit cur, nxt; int ui = 0;
    if (!S.next(0, cur)) return;
    f32x4 acc[2][2][4][2];
#pragma unroll
    for (int a = 0; a < 2; ++a)
#pragma unroll
        for (int b = 0; b < 2; ++b)
#pragma unroll
            for (int m = 0; m < 4; ++m)
#pragma unroll
                for (int n = 0; n < 2; ++n) acc[a][b][m][n] = (f32x4){0.f, 0.f, 0.f, 0.f};
    bf16x8 At[4][2], B0[2][2], B1[2][2];
    const char* cA = (const char*)g.A + (GATHER ? (size_t)0 : (size_t)cur.pm * tstep);
    const char* cB = (const char*)g.Bt + (size_t)cur.e * g.bstride + (size_t)cur.pn * tstep;
    if constexpr (GATHER) S.a_rows(cur, vA, RA, CA, K);
    PG8_STAGE(PG8_SB(0, 0), cB, voffB); PG8_STAGE(PG8_SB(0, 1), cB + hstep, voffB); PG8_STAGE(PG8_SA(0, 0), cA, vA[0]); PG8_STAGE(PG8_SA(0, 1), cA, vA[1]);
    if (wr == 1) PG8_BAR;
    PG8_WAIT_V(2); PG8_BAR;
    PG8_STAGE(PG8_SB(1, 0), cB + kstep, voffB); PG8_STAGE(PG8_SA(1, 0), cA + kstep, vA[0]); PG8_STAGE(PG8_SB(1, 1), cB + hstep + kstep, voffB);
    PG8_WAIT_V(6); PG8_BAR;
    for (;;) {
        const bool has_next = S.next(ui + 1, nxt);
        const char* nA = has_next ? (const char*)g.A + (GATHER ? (size_t)0 : (size_t)nxt.pm * tstep) : cA;
        const char* nB = has_next ? (const char*)g.Bt + (size_t)nxt.e * g.bstride + (size_t)nxt.pn * tstep : cB;
        if constexpr (GATHER) { if (has_next) S.a_rows(nxt, vAn, RA, CA, K); }
        for (int t = 0; t < nt; t += 2) {
            const bool last = (t == nt - 2);
            const char* a1 = cA + (size_t)(t + 1) * kstep;
            const char* a2 = last ? nA : cA + (size_t)(t + 2) * kstep; const char* b2 = last ? nB : cB + (size_t)(t + 2) * kstep;
            const char* a3 = a2 + kstep; const char* b3 = b2 + kstep;
            unsigned vX[2][2];
#pragma unroll
            for (int h = 0; h < 2; ++h)
#pragma unroll
                for (int i = 0; i < 2; ++i) vX[h][i] = (GATHER && last) ? vAn[h][i] : vA[h][i];
            PG8_LDB(B0, 0, 0); PG8_LDB(B1, 0, 1); PG8_SCHED; PG8_LDA(At, 0, 0); PG8_STAGE(PG8_SA(1, 1), a1, vA[1]);
            PG8_WAIT_V(8); PG8_WAIT_L(0); PG8_BAR; PG8_MMA(0, 0, At, B0); PG8_MMA(0, 1, At, B1); PG8_BAR; PG8_SCHED;
            PG8_LDA(At, 0, 1); PG8_STAGE(PG8_SB(0, 0), b2, voffB); PG8_STAGE(PG8_SB(0, 1), b2 + hstep, voffB); PG8_STAGE(PG8_SA(0, 0), a2, vX[0]);
            PG8_WAIT_V(8); PG8_WAIT_L(0); PG8_BAR; PG8_MMA(1, 0, At, B0); PG8_MMA(1, 1, At, B1); PG8_BAR; PG8_SCHED;
            PG8_LDB(B0, 1, 0); PG8_LDB(B1, 1, 1); PG8_SCHED; PG8_LDA(At, 1, 0); PG8_STAGE(PG8_SA(0, 1), a2, vX[1]);
            PG8_WAIT_V(8); PG8_WAIT_L(0); PG8_BAR; PG8_MMA(0, 0, At, B0); PG8_MMA(0, 1, At, B1); PG8_BAR; PG8_SCHED;
            PG8_LDA(At, 1, 1); PG8_STAGE(PG8_SB(1, 0), b3, voffB); PG8_STAGE(PG8_SB(1, 1), b3 + hstep, voffB); PG8_STAGE(PG8_SA(1, 0), a3, vX[0]);
            PG8_WAIT_V(8); PG8_WAIT_L(0); PG8_BAR; PG8_MMA(1, 0, At, B0); PG8_MMA(1, 1, At, B1); PG8_BAR; PG8_SCHED;
        }
        if constexpr (ALIGN_EPI) { if (wr == 0) PG8_BAR; }
        E(acc, cur, wr, wc, fr, fq);
        if (!has_next) break;
#pragma unroll
        for (int a = 0; a < 2; ++a)
#pragma unroll
            for (int b = 0; b < 2; ++b)
#pragma unroll
                for (int m = 0; m < 4; ++m)
#pragma unroll
                    for (int n = 0; n < 2; ++n) acc[a][b][m][n] = (f32x4){0.f, 0.f, 0.f, 0.f};
        cur = nxt; cA = nA; cB = nB; ++ui;
        if constexpr (GATHER) {
#pragma unroll
            for (int h = 0; h < 2; ++h)
#pragma unroll
                for (int i = 0; i < 2; ++i) vA[h][i] = vAn[h][i]; }
        if constexpr (ALIGN_EPI) { if (wr == 1) PG8_BAR; }
    }
    PG8_WAIT_V(0);
    if constexpr (!ALIGN_EPI) { if (wr == 0) PG8_BAR; }
    PG8_BAR;
#undef PG8_SA
#undef PG8_SB
#undef PG8_STAGE
#undef PG8_LDA
#undef PG8_LDB
#undef PG8_MMA
#undef PG8_WAIT_V
#undef PG8_WAIT_L
#undef PG8_BAR
#undef PG8_SCHED
}
}

constexpr int T = 8192, D = 2048, NIN = 19456;
constexpr int C_QA = 0, C_KA = 3072, C_VA = 6144, C_QR = 9216, C_KR = 10240, C_VR = 11264, C_GR = 13312, C_GA = 15360, C_GB = 17408;
constexpr int NEXP = 32, EHID = 512, LCAP = 8192;
constexpr float ALPHA = 1.189207115002721f;
constexpr float LN_EPS = 1e-5f;
constexpr float QK_SCALE = 0.08838834764831845f;
constexpr int NWAVES = 8;
constexpr size_t MiB = 1u << 20;
constexpr size_t WS_CTL = 0, CTL_ZERO_BYTES = 1 * MiB;
constexpr size_t WS_COSA = 1 * MiB, WS_SINA = WS_COSA + 512 * 1024, WS_COSR = 2 * MiB, WS_SINR = 4 * MiB;
constexpr size_t WS_ASGW = 6 * MiB, WS_ASGE = WS_ASGW + 64 * 1024, WS_LIST = WS_ASGW + 256 * 1024;
constexpr size_t WS_LSE = 7 * MiB + 512 * 1024;
constexpr size_t WS_WAT = 10 * MiB, WS_WRT = 14 * MiB, WS_WOT = 22 * MiB;
constexpr size_t WS_XB = 30 * MiB, WS_WINT = 62 * MiB;
constexpr size_t WS_PROJ = 138 * MiB;
constexpr size_t WS_OAG = 30 * MiB, WS_KV = 78 * MiB, WS_OA = 110 * MiB;
constexpr size_t WS_ST = 442 * MiB, WS_OR = 474 * MiB, WS_TMP = 506 * MiB, WS_MERGED = 570 * MiB;
constexpr size_t WS_WGU = 138 * MiB, WS_WD = 266 * MiB, WS_X1B = 330 * MiB, WS_HID = 362 * MiB, WS_YBUF = 386 * MiB;
constexpr size_t WS_END = 602 * MiB;
constexpr int CW_BAR = 4096;
constexpr int CW_CNT = 16384;
constexpr int RING_OFF = 0, RING_BYTES = 131072;
constexpr int LDSCTL_OFF = RING_BYTES, MISC_OFF = LDSCTL_OFF + 320;
constexpr int MOE_TAB_OFF = RING_BYTES + 1024, MOE_CNT_OFF = MOE_TAB_OFF + 512;
constexpr int LDS_BYTES = 147456;

#define GAS __attribute__((address_space(1)))
#define LAS __attribute__((address_space(3)))
typedef unsigned short bf16;
typedef unsigned v4u __attribute__((ext_vector_type(4)));
typedef unsigned v2u __attribute__((ext_vector_type(2)));
typedef float f32x4 __attribute__((ext_vector_type(4)));
typedef GAS unsigned gu32;
#define RLX_AGENT __ATOMIC_RELAXED, __HIP_MEMORY_SCOPE_AGENT
#define LDS_WAIT() asm volatile("s_waitcnt lgkmcnt(0)" ::: "memory")
#define VM_WAIT() asm volatile("s_waitcnt vmcnt(0)" ::: "memory")
__device__ __forceinline__ unsigned f2bf(float f) { unsigned u = __builtin_bit_cast(unsigned, f); return (u + 0x7fffu + ((u >> 16) & 1u)) >> 16; }
__device__ __forceinline__ unsigned pk2(float lo, float hi) { return f2bf(lo) | (f2bf(hi) << 16); }
__device__ __forceinline__ float bflo(unsigned w) { return __builtin_bit_cast(float, w << 16); }
__device__ __forceinline__ float bfhi(unsigned w) { return __builtin_bit_cast(float, w & 0xffff0000u); }
__device__ __forceinline__ float bf2f(bf16 b) { return __builtin_bit_cast(float, (unsigned)b << 16); }
__device__ __forceinline__ float wave_sum(float v) {
#pragma unroll
    for (int o = 1; o < 64; o <<= 1) v += __shfl_xor(v, o);
    return v;
}
__device__ __forceinline__ float wave_max(float v) {
#pragma unroll
    for (int o = 1; o < 64; o <<= 1) v = fmaxf(v, __shfl_xor(v, o));
    return v;
}
__device__ __forceinline__ float sigmoidf_(float x) { return 1.f / (1.f + __expf(-x)); }

#define XB_TMO      128
#define XB_XCNT(j)  (256  + 64 * (j))
#define XB_XSUB(j)  (1280 + 64 * (j))
#define XB_XGEN(j)  (2304 + 64 * (j))
#define XB_TOP      3328
#define XB_TOPGEN   3392
#define XCD_BAR_WORDS 3456
#define XB_SPIN_CAP (1u << 18)

__device__ __forceinline__ unsigned xb_ld(unsigned* p)              { return __hip_atomic_load(p, __ATOMIC_RELAXED, __HIP_MEMORY_SCOPE_AGENT); }
__device__ __forceinline__ unsigned xb_add(unsigned* p, unsigned v) { return __hip_atomic_fetch_add(p, v, __ATOMIC_RELAXED, __HIP_MEMORY_SCOPE_AGENT); }
__device__ __forceinline__ unsigned xb_xcc_id() { return (unsigned)__builtin_amdgcn_s_getreg((3 << 11) | 20) & 0xFu; }
#define XB_SPIN(cond, bar) do { unsigned _sp = 0; while (cond) { __builtin_amdgcn_s_sleep(1); \
    if ((++_sp & 255u) == 0u) { if (xb_ld(&(bar)[XB_TMO])) break; if (_sp > XB_SPIN_CAP) { atomicAdd(&(bar)[XB_TMO], 1u); break; } } } } while (0)

struct XcdBarrier {
    unsigned* bar; unsigned x;
    volatile LAS unsigned* st;
};

__device__ __forceinline__ XcdBarrier xcd_barrier_post(unsigned* bar, volatile LAS unsigned* st) {
    XcdBarrier b; b.bar = bar; b.x = xb_xcc_id(); b.st = st;
    if (threadIdx.x == 0) (void)xb_add(&bar[XB_XCNT(b.x)], 1u);
    return b;
}
__device__ __forceinline__ void xcd_barrier_complete(unsigned* bar, unsigned x, unsigned& nloc, unsigned& nx) {
    const unsigned G = gridDim.x * gridDim.y * gridDim.z;
    unsigned sum, cnt, mine, sp = 0u;
    for (;;) {
        sum = 0u; cnt = 0u; mine = 0u;
#pragma unroll
        for (unsigned j = 0; j < 16; ++j) { const unsigned c = xb_ld(&bar[XB_XCNT(j)]); sum += c; cnt += (c > 0u) ? 1u : 0u; mine = (j == x) ? c : mine; }
        if (sum == G) break;
        __builtin_amdgcn_s_sleep(1);
        if ((++sp & 255u) == 0u) { if (xb_ld(&bar[XB_TMO])) break; if (sp > XB_SPIN_CAP) { atomicAdd(&bar[XB_TMO], 1u); break; } }
    }
    nloc = mine > 0u ? mine : 1u; nx = cnt > 0u ? cnt : 1u;
}

__device__ __forceinline__ void xcd_barrier(const XcdBarrier& b) {
    asm volatile("s_waitcnt vmcnt(0)" ::: "memory");
    __syncthreads();
    if (threadIdx.x == 0) {
        unsigned* bar = b.bar;
        __builtin_amdgcn_s_waitcnt(0);
        unsigned nloc = b.st[0], nx = b.st[1];
        if (nloc == 0u) { xcd_barrier_complete(bar, b.x, nloc, nx); b.st[0] = nloc; b.st[1] = nx; }
        const unsigned old = xb_add(&bar[XB_XSUB(b.x)], 1u);
        const unsigned gen = old / nloc;
        if (old + 1u == (gen + 1u) * nloc) {
            __builtin_amdgcn_fence(__ATOMIC_RELEASE, "agent");
            asm volatile("s_waitcnt vmcnt(0)" ::: "memory");
            const unsigned og = xb_add(&bar[XB_TOP], 1u);
            const unsigned tg = og / nx;
            if (og + 1u == (tg + 1u) * nx) xb_add(&bar[XB_TOPGEN], 1u);
            else XB_SPIN(xb_ld(&bar[XB_TOPGEN]) == tg, bar);
            __builtin_amdgcn_fence(__ATOMIC_ACQUIRE, "agent");
            xb_add(&bar[XB_XGEN(b.x)], 1u);
            asm volatile("s_waitcnt vmcnt(0)" ::: "memory");
        } else {
            XB_SPIN(xb_ld(&bar[XB_XGEN(b.x)]) == gen, bar);
            __builtin_amdgcn_fence(__ATOMIC_ACQUIRE, "agent");
            asm volatile("s_waitcnt vmcnt(0)" ::: "memory");
        }
    }
    __syncthreads();
}

struct Frame {
    LAS unsigned char* lds;
    volatile LAS unsigned* MISC;
    gu32* ctl;
    int tid, lane, wave;
    int vcu, G;
    float* out; unsigned char* ws;
};
struct Args { const float* in[17]; float* out; unsigned char* ws; int ph_lo, ph_hi; };
#define WSP(type, off) ((type*)(F.ws + (off)))
enum { I_X = 0, I_POS, I_WIN, I_WBA, I_WBR, I_WOUT, I_LN1S, I_LN1B, I_WGR, I_BGR, I_WER, I_BER, I_WEG, I_WEU, I_WED, I_LN2S, I_LN2B };

__device__ __forceinline__ float logdecay(int h) { return log1pf(-exp2f(-5.f - (float)h)); }

__device__ __forceinline__ int win_src_col(int n) {
    if (n < C_VA) { int j = n & 127; if (j < 32) j = ((j & 1) << 4) + (j >> 1); return (n & ~127) + j; }
    if (n >= C_QR && n < C_VR) { int j = n & 127; j = ((j & 1) << 6) + (j >> 1); return (n & ~127) + j; }
    return n;
}
__device__ __forceinline__ void tr_item(const float* W, size_t ldw, int sc, int k0, bf16* WT, size_t ldt, int dr0, LAS float* scr, int lane) {
#pragma unroll 8
    for (int i = 0; i < 32; ++i) { const int kk = 2 * i + (lane >> 5); scr[kk * 33 + (lane & 31)] = W[(size_t)(k0 + kk) * ldw + sc]; }
    LDS_WAIT(); asm volatile("" ::: "memory");
    const int c = lane & 7;
#pragma unroll
    for (int j = 0; j < 4; ++j) { const int n = (lane >> 3) + 8 * j; const LAS float* s = scr + (8 * c) * 33 + n;
        v4u o; o.x = pk2(s[0 * 33], s[1 * 33]); o.y = pk2(s[2 * 33], s[3 * 33]); o.z = pk2(s[4 * 33], s[5 * 33]); o.w = pk2(s[6 * 33], s[7 * 33]);
        *(GAS v4u*)(WT + (size_t)(dr0 + n) * ldt + k0 + 8 * c) = o; }
    LDS_WAIT(); asm volatile("" ::: "memory");
}
__device__ __forceinline__ void p0_prologue(Frame& F, const Args& A) {
    LAS float* scr = (LAS float*)(F.lds + RING_OFF + F.wave * 16384);
    const int gw = F.vcu * NWAVES + F.wave, NGW = F.G * NWAVES;
    constexpr int I_IN = 32 * 608, I_A = 16 * 64, I_R = 32 * 64, I_O = 32 * 64, NITEMS = I_IN + I_A + I_R + I_O;
    for (int it = gw; it < NITEMS; it += NGW) {
        int r = it;
        if (r < I_IN) { const int kb = r / 608, nb = r % 608; tr_item(A.in[I_WIN], NIN, win_src_col(32 * nb + (F.lane & 31)), 64 * kb, WSP(bf16, WS_WINT), D, 32 * nb, scr, F.lane); continue; } r -= I_IN;
        if (r < I_A) { const int kb = r / 64, nb = r % 64; tr_item(A.in[I_WBA], D, 32 * nb + (F.lane & 31), 64 * kb, WSP(bf16, WS_WAT), 1024, 32 * nb, scr, F.lane); continue; } r -= I_A;
        if (r < I_R) { const int kb = r / 64, nb = r % 64; tr_item(A.in[I_WBR], D, 32 * nb + (F.lane & 31), 64 * kb, WSP(bf16, WS_WRT), 2048, 32 * nb, scr, F.lane); continue; } r -= I_R;
        { const int kb = r / 64, nb = r % 64; tr_item(A.in[I_WOUT], D, 32 * nb + (F.lane & 31), 64 * kb, WSP(bf16, WS_WOT), 2048, 32 * nb, scr, F.lane); }
    }
    const int gt = F.vcu * 512 + F.tid, NGT = F.G * 512;
    { const GAS f32x4* x4 = (const GAS f32x4*)A.in[I_X]; GAS v4u* xb = (GAS v4u*)WSP(bf16, WS_XB);
      for (int i = gt; i < T * D / 8; i += NGT) { const f32x4 a = x4[2 * i], b = x4[2 * i + 1]; v4u o; o.x = pk2(a.x, a.y); o.y = pk2(a.z, a.w); o.z = pk2(b.x, b.y); o.w = pk2(b.z, b.w); xb[i] = o; } }
    { const int* pos = (const int*)A.in[I_POS]; float* cA = WSP(float, WS_COSA); float* sA = WSP(float, WS_SINA); float* cR = WSP(float, WS_COSR); float* sR = WSP(float, WS_SINR);
      for (int i = gt; i < T * 80; i += NGT) { const int t = i / 80, j = i % 80;
        const double inv = (j < 16) ? exp(-((double)(2 * j) / 32.0) * 13.122363377404328)   : exp(-((double)(j - 16) / 63.0) * 9.210340371976184)  ;
        const double a = (double)pos[t] * inv, n = rint(a * 0.15915494309189535), r = a - n * 6.283185307179586;
        const float c = cosf((float)r), s = sinf((float)r);
        if (j < 16) { cA[t * 16 + j] = c; sA[t * 16 + j] = s; } else { cR[t * 64 + j - 16] = c; sR[t * 64 + j - 16] = s; } } }
}
#define EPI_LOOP_BEGIN const int row0 = u.pm * 256 + wr * 64 + fr; const int colw = wc * 32 + 8 * fq; \
    _Pragma("unroll") for (int ai = 0; ai < 2; ++ai) _Pragma("unroll") for (int m = 0; m < 4; ++m) { const int row = row0 + ai * 128 + m * 16; \
    _Pragma("unroll") for (int bj = 0; bj < 2; ++bj) { f32x4 v0 = acc[ai][bj][m][0], v1 = acc[ai][bj][m][1]; const int col = u.pn * 256 + bj * 128 + colw;
#define EPI_LOOP_END } }
__device__ __forceinline__ v4u pack8(const f32x4& v0, const f32x4& v1) { v4u w; w.x = pg8::cvt_pk_bf16(v0[0], v0[1]); w.y = pg8::cvt_pk_bf16(v0[2], v0[3]); w.z = pg8::cvt_pk_bf16(v1[0], v1[1]); w.w = pg8::cvt_pk_bf16(v1[2], v1[3]); return w; }
__device__ __forceinline__ void unpack8(const v4u w, f32x4& a, f32x4& b) { a = (f32x4){bflo(w.x), bfhi(w.x), bflo(w.y), bfhi(w.y)}; b = (f32x4){bflo(w.z), bfhi(w.z), bflo(w.w), bfhi(w.w)}; }
__device__ __forceinline__ void rot8(f32x4& v0, f32x4& v1, const f32x4 c, const f32x4 s) {
    float a, b;
    a = v0[0]; b = v0[1]; v0[0] = a * c[0] - b * s[0]; v0[1] = b * c[0] + a * s[0];
    a = v0[2]; b = v0[3]; v0[2] = a * c[1] - b * s[1]; v0[3] = b * c[1] + a * s[1];
    a = v1[0]; b = v1[1]; v1[0] = a * c[2] - b * s[2]; v1[1] = b * c[2] + a * s[2];
    a = v1[2]; b = v1[3]; v1[2] = a * c[3] - b * s[3]; v1[3] = b * c[3] + a * s[3];
}
struct EpiProj {
    bf16* O; const float *cosA, *sinA, *cosR, *sinR;
    __device__ __forceinline__ void operator()(const f32x4 (&acc)[2][2][4][2], const pg8::Unit& u, int wr, int wc, int fr, int fq) const {
        const int colt = u.pn * 256;
        int kind = 0;
        if (colt < C_VA) kind = 1; else if (colt < C_QR) kind = 0; else if (colt < C_KR) kind = 2; else if (colt < C_VR) kind = 3; else if (colt < C_GR) kind = 0; else if (colt < C_GA) kind = 4; else kind = 5;
        EPI_LOOP_BEGIN
            if (kind == 1) { if (wc == 0) { const f32x4 c = *(const f32x4*)(cosA + (size_t)row * 16 + 4 * fq), s = *(const f32x4*)(sinA + (size_t)row * 16 + 4 * fq); rot8(v0, v1, c, s); } }
            else if (kind == 2 || kind == 3) { const int i0 = wc * 16 + 4 * fq; const f32x4 c = *(const f32x4*)(cosR + (size_t)row * 64 + i0), s = *(const f32x4*)(sinR + (size_t)row * 64 + i0); rot8(v0, v1, c, s);
                if (kind == 3) { v0 = v0 * QK_SCALE; v1 = v1 * QK_SCALE; } }
            else if (kind == 4) {
#pragma unroll
                for (int j = 0; j < 4; ++j) { v0[j] = v0[j] * sigmoidf_(v0[j]); v1[j] = v1[j] * sigmoidf_(v1[j]); } }
            else if (kind == 5) {
#pragma unroll
                for (int j = 0; j < 4; ++j) { v0[j] = sigmoidf_(v0[j]); v1[j] = sigmoidf_(v1[j]); } }
            *(v4u*)(O + (size_t)row * NIN + col) = pack8(v0, v1);
        EPI_LOOP_END
    }
};
struct EpiTmp {
    float* tmp; const bf16* proj;
    __device__ __forceinline__ void operator()(const f32x4 (&acc)[2][2][4][2], const pg8::Unit& u, int wr, int wc, int fr, int fq) const {
        EPI_LOOP_BEGIN
            f32x4 g0, g1; unpack8(*(const v4u*)(proj + (size_t)row * NIN + C_GA + col), g0, g1);
            *(f32x4*)(tmp + (size_t)row * D + col) = v0 * g0; *(f32x4*)(tmp + (size_t)row * D + col + 4) = v1 * g1;
        EPI_LOOP_END
    }
};
struct EpiMerged {
    const float* tmp; const bf16* proj; bf16* merged;
    __device__ __forceinline__ void operator()(const f32x4 (&acc)[2][2][4][2], const pg8::Unit& u, int wr, int wc, int fr, int fq) const {
        EPI_LOOP_BEGIN
            f32x4 g0, g1; unpack8(*(const v4u*)(proj + (size_t)row * NIN + C_GB + col), g0, g1);
            const f32x4 t0 = *(const f32x4*)(tmp + (size_t)row * D + col), t1 = *(const f32x4*)(tmp + (size_t)row * D + col + 4);
            v0 = t0 + v0 * g0; v1 = t1 + v1 * g1;
            *(v4u*)(merged + (size_t)row * D + col) = pack8(v0, v1);
        EPI_LOOP_END
    }
};
struct EpiR1 {
    const float* x; float* r1;
    __device__ __forceinline__ void operator()(const f32x4 (&acc)[2][2][4][2], const pg8::Unit& u, int wr, int wc, int fr, int fq) const {
        EPI_LOOP_BEGIN
            const f32x4 x0 = *(const f32x4*)(x + (size_t)row * D + col), x1 = *(const f32x4*)(x + (size_t)row * D + col + 4);
            *(f32x4*)(r1 + (size_t)row * D + col) = x0 * ALPHA + v0; *(f32x4*)(r1 + (size_t)row * D + col + 4) = x1 * ALPHA + v1;
        EPI_LOOP_END
    }
};
__device__ __forceinline__ float dot128(const bf16* a, const bf16* b) {
    float s = 0.f;
#pragma unroll
    for (int x = 0; x < 16; ++x) { const v4u qa = *(const GAS v4u*)(a + 8 * x), kb = *(const GAS v4u*)(b + 8 * x);
        s += bflo(qa.x) * bflo(kb.x) + bfhi(qa.x) * bfhi(kb.x) + bflo(qa.y) * bflo(kb.y) + bfhi(qa.y) * bfhi(kb.y) + bflo(qa.z) * bflo(kb.z) + bfhi(qa.z) * bfhi(kb.z) + bflo(qa.w) * bflo(kb.w) + bfhi(qa.w) * bfhi(kb.w); }
    return s;
}
__device__ __forceinline__ void p2_attn_ref(Frame& F, const Args& A) {
    const bf16* proj = WSP(bf16, WS_PROJ); bf16* oag = WSP(bf16, WS_OAG); float* lse = WSP(float, WS_LSE);
    const int gw = F.vcu * NWAVES + F.wave, NGW = F.G * NWAVES, lane = F.lane;
    for (int it = gw; it < 3 * 8 * T; it += NGW) {
        const int g = it / (8 * T), rem = it % (8 * T), t = rem >> 3, h = rem & 7;
        const int d = (g == 0) ? 1 : (g == 1 ? 4 : 16);
        const int m = t / d, nk = (m < 128 ? m : 128) + 1;
        const size_t hc = (size_t)(g * 8 + h) * 128;
        const bf16* q = proj + (size_t)t * NIN + C_QA + hc;
        float sc[3];
#pragma unroll
        for (int j = 0; j < 3; ++j) { const int s = lane + 64 * j; float a = -__builtin_inff();
            if (s < nk) a = dot128(q, proj + (size_t)(t - s * d) * NIN + C_KA + hc) * QK_SCALE;
            sc[j] = a; }
        const float mx = wave_max(fmaxf(sc[0], fmaxf(sc[1], sc[2])));
        float p[3];
#pragma unroll
        for (int j = 0; j < 3; ++j) p[j] = (lane + 64 * j < nk) ? __expf(sc[j] - mx) : 0.f;
        const float sum = wave_sum(p[0] + p[1] + p[2]);
        float o0 = 0.f, o1 = 0.f;
        for (int s = 0; s < nk; ++s) { const float pj = (s < 64) ? p[0] : (s < 128 ? p[1] : p[2]); const float pv = __shfl(pj, s & 63);
            const unsigned vv = *(const GAS unsigned*)(proj + (size_t)(t - s * d) * NIN + C_VA + hc + 2 * lane); o0 += pv * bflo(vv); o1 += pv * bfhi(vv); }
        const float rs = 1.f / sum;
        *(GAS unsigned*)(oag + ((size_t)g * T + t) * 1024 + h * 128 + 2 * lane) = pk2(o0 * rs, o1 * rs);
        if (lane == 0) lse[((size_t)g * T + t) * 8 + h] = mx + __logf(sum);
    }
}
__device__ __forceinline__ void p2_kv_ref(Frame& F, const Args& A) {
    const bf16* proj = WSP(bf16, WS_PROJ); bf16* kvT = WSP(bf16, WS_KV);
    const int gt = F.vcu * 512 + F.tid, NGT = F.G * 512;
    for (int idx = gt; idx < 64 * 8 * 256 * 128; idx += NGT) {
        const int d = idx & 127, e = (idx >> 7) & 255, h = (idx >> 15) & 7, c = idx >> 18;
        const float ld = logdecay(h); float acc = 0.f;
        for (int m = 0; m < 128; ++m) { const size_t r = (size_t)(c * 128 + m) * NIN;
            acc += bf2f(proj[r + C_KR + h * 128 + d]) * __expf((float)(127 - m) * ld) * bf2f(proj[r + C_VR + h * 256 + e]); }
        kvT[idx] = (bf16)f2bf(acc);
    }
}
__device__ __forceinline__ void p3_scan_combine(Frame& F, const Args& A) {
    const int gt = F.vcu * 512 + F.tid, NGT = F.G * 512;
    { const GAS unsigned* kv = (const GAS unsigned*)WSP(bf16, WS_KV); GAS unsigned* st = (GAS unsigned*)WSP(bf16, WS_ST);
      for (int i = gt; i < 131072; i += NGT) {
        const int h = i >> 14; const float dc = __expf(128.f * logdecay(h)); float s0 = 0.f, s1 = 0.f;
#pragma unroll 8
        for (int c = 0; c < 64; ++c) { const unsigned w = kv[(size_t)c * 131072 + i]; st[(size_t)c * 131072 + i] = pk2(s0, s1); s0 = dc * s0 + bflo(w); s1 = dc * s1 + bfhi(w); } } }
    { const bf16* oag = WSP(bf16, WS_OAG); const float* lse = WSP(float, WS_LSE); bf16* oa = WSP(bf16, WS_OA);
      for (int i = gt; i < T * 128; i += NGT) {
        const int t = i >> 7, ch = i & 127, h = ch >> 4;
        const float l0 = lse[(size_t)t * 8 + h], l1 = lse[((size_t)T + t) * 8 + h], l2 = lse[((size_t)2 * T + t) * 8 + h];
        const float mx = fmaxf(l0, fmaxf(l1, l2)); const float e0 = __expf(l0 - mx), e1 = __expf(l1 - mx), e2 = __expf(l2 - mx); const float rs = 1.f / (e0 + e1 + e2);
        f32x4 a0, a1, b0, b1, c0, c1;
        unpack8(*(const GAS v4u*)(oag + (size_t)t * 1024 + ch * 8), a0, a1); unpack8(*(const GAS v4u*)(oag + ((size_t)T + t) * 1024 + ch * 8), b0, b1); unpack8(*(const GAS v4u*)(oag + ((size_t)2 * T + t) * 1024 + ch * 8), c0, c1);
        const f32x4 r0 = (a0 * e0 + b0 * e1 + c0 * e2) * rs, r1 = (a1 * e0 + b1 * e1 + c1 * e2) * rs;
        v4u o; o.x = pk2(r0[0], r0[1]); o.y = pk2(r0[2], r0[3]); o.z = pk2(r1[0], r1[1]); o.w = pk2(r1[2], r1[3]);
        *(GAS v4u*)(oa + (size_t)t * 1024 + ch * 8) = o; } }
}
__device__ __forceinline__ void p4_ret_ref(Frame& F, const Args& A) {
    const bf16* proj = WSP(bf16, WS_PROJ); const bf16* stT = WSP(bf16, WS_ST); bf16* orr = WSP(bf16, WS_OR);
    const int gw = F.vcu * NWAVES + F.wave, NGW = F.G * NWAVES, lane = F.lane;
    for (int it = gw; it < T * 8; it += NGW) {
        const int t = it >> 3, h = it & 7, n = t & 127, c = t >> 7; const float ld = logdecay(h);
        const bf16* q = proj + (size_t)t * NIN + C_QR + h * 128;
        float sc[2];
#pragma unroll
        for (int j = 0; j < 2; ++j) { const int m = lane + 64 * j; float a = 0.f;
            if (m <= n) a = dot128(q, proj + (size_t)(c * 128 + m) * NIN + C_KR + h * 128) * __expf((float)(n - m) * ld);
            sc[j] = a; }
        float o[4] = {0.f, 0.f, 0.f, 0.f};
        for (int m = 0; m <= n; ++m) { const float pv = __shfl((m < 64) ? sc[0] : sc[1], m & 63); const bf16* v = proj + (size_t)(c * 128 + m) * NIN + C_VR + h * 256;
#pragma unroll
            for (int j = 0; j < 4; ++j) o[j] += pv * bf2f(v[lane + 64 * j]); }
        const float qd = __expf((float)(n + 1) * ld);
#pragma unroll
        for (int j = 0; j < 4; ++j) { const int e = lane + 64 * j; o[j] += qd * dot128(q, stT + ((size_t)(c * 8 + h) * 256 + e) * 128); }
        const float mean = wave_sum(o[0] + o[1] + o[2] + o[3]) * (1.f / 256.f);
        float q2 = 0.f;
#pragma unroll
        for (int j = 0; j < 4; ++j) { o[j] -= mean; q2 += o[j] * o[j]; }
        const float rstd = 1.f / sqrtf(wave_sum(q2) * (1.f / 256.f) + LN_EPS);
#pragma unroll
        for (int j = 0; j < 4; ++j) { const int e = lane + 64 * j; orr[(size_t)t * D + h * 256 + e] = (bf16)f2bf(bf2f(proj[(size_t)t * NIN + C_GR + h * 256 + e]) * o[j] * rstd); }
    }
}
__device__ __forceinline__ void p7_ln_router(Frame& F, const Args& A) {
    const int gw = F.vcu * NWAVES + F.wave, NGW = F.G * NWAVES, lane = F.lane;
    float* x1 = F.out; bf16* x1b = WSP(bf16, WS_X1B); float* asgw = WSP(float, WS_ASGW); int* asge = WSP(int, WS_ASGE); int* list = WSP(int, WS_LIST);
    LAS float* xs = (LAS float*)(F.lds + RING_OFF + F.wave * 16384);
    for (int t = gw; t < T; t += NGW) {
        { const GAS f32x4* sc4 = (const GAS f32x4*)A.in[I_LN1S]; const GAS f32x4* bi4 = (const GAS f32x4*)A.in[I_LN1B];
          GAS f32x4* xr = (GAS f32x4*)(x1 + (size_t)t * D) + lane;
          f32x4 v[8]; float s = 0.f;
#pragma unroll
          for (int j = 0; j < 8; ++j) { v[j] = xr[64 * j]; s += (v[j].x + v[j].y) + (v[j].z + v[j].w); }
          const float mean = wave_sum(s) * (1.f / D); float s2 = 0.f;
#pragma unroll
          for (int j = 0; j < 8; ++j) { v[j] = v[j] - mean; s2 += (v[j].x * v[j].x + v[j].y * v[j].y) + (v[j].z * v[j].z + v[j].w * v[j].w); }
          const float rstd = 1.f / sqrtf(wave_sum(s2) * (1.f / D) + LN_EPS);
          GAS v2u* o8 = (GAS v2u*)(x1b + (size_t)t * D) + lane;
#pragma unroll
          for (int j = 0; j < 8; ++j) { v[j] = v[j] * rstd * sc4[lane + 64 * j] + bi4[lane + 64 * j]; xr[64 * j] = v[j];
              v2u w; w.x = pk2(v[j].x, v[j].y); w.y = pk2(v[j].z, v[j].w); o8[64 * j] = w; *(LAS f32x4*)(xs + 4 * (lane + 64 * j)) = v[j]; } }
        LDS_WAIT(); asm volatile("" ::: "memory");
        float gl[4] = {0.f, 0.f, 0.f, 0.f};
        { const GAS f32x4* wg4 = (const GAS f32x4*)A.in[I_WGR];
#pragma unroll 4
          for (int i = 0; i < 32; ++i) { const int dd = lane + 64 * i; const f32x4 wv = wg4[dd]; const float xv = xs[dd]; gl[0] += xv * wv.x; gl[1] += xv * wv.y; gl[2] += xv * wv.z; gl[3] += xv * wv.w; } }
        const float* bg = A.in[I_BGR];
#pragma unroll
        for (int q = 0; q < 4; ++q) gl[q] = wave_sum(gl[q]) + bg[q];
        int gs = 0; float gm = gl[0];
#pragma unroll
        for (int q = 1; q < 4; ++q) if (gl[q] > gm) { gm = gl[q]; gs = q; }
        const float pg = 1.f / (__expf(gl[0] - gm) + __expf(gl[1] - gm) + __expf(gl[2] - gm) + __expf(gl[3] - gm));
        float el[8] = {0.f, 0.f, 0.f, 0.f, 0.f, 0.f, 0.f, 0.f};
        { const GAS f32x4* we4 = (const GAS f32x4*)(A.in[I_WER] + (size_t)gs * D * 8);
#pragma unroll 4
          for (int i = 0; i < 32; ++i) { const int dd = lane + 64 * i; const f32x4 w0 = we4[dd * 2], w1 = we4[dd * 2 + 1]; const float xv = xs[dd];
              el[0] += xv * w0.x; el[1] += xv * w0.y; el[2] += xv * w0.z; el[3] += xv * w0.w; el[4] += xv * w1.x; el[5] += xv * w1.y; el[6] += xv * w1.z; el[7] += xv * w1.w; } }
        const float* be = A.in[I_BER];
#pragma unroll
        for (int q = 0; q < 8; ++q) el[q] = wave_sum(el[q]) + be[gs * 8 + q];
        int i1 = 0; float v1 = el[0];
#pragma unroll
        for (int q = 1; q < 8; ++q) if (el[q] > v1) { v1 = el[q]; i1 = q; }
        int i2 = -1; float v2 = -__builtin_inff();
#pragma unroll
        for (int q = 0; q < 8; ++q) if (q != i1 && el[q] > v2) { v2 = el[q]; i2 = q; }
        const float e2 = __expf(v2 - v1); const float w1 = pg / (1.f + e2), w2 = pg * e2 / (1.f + e2);
        if (lane < 2) { const int ex = gs * 8 + (lane == 0 ? i1 : i2); const int a = t * 2 + lane;
            const unsigned pos = __hip_atomic_fetch_add((unsigned*)(F.ctl + CW_CNT + 64 * ex), 1u, RLX_AGENT);
            list[ex * LCAP + pos] = a; asgw[a] = (lane == 0) ? w1 : w2; asge[a] = ex; }
        LDS_WAIT(); asm volatile("" ::: "memory");
    }
}
__device__ __forceinline__ void p7_expert_weights(Frame& F, const Args& A) {
    LAS float* scr = (LAS float*)(F.lds + RING_OFF + F.wave * 16384);
    const int gw = F.vcu * NWAVES + F.wave, NGW = F.G * NWAVES;
    for (int it = gw; it < NEXP * 1536; it += NGW) {
        const int e = it / 1536; int r = it % 1536;
        if (r < 1024) { const int up = r >> 9; r &= 511; const int kb = r >> 4, nb = r & 15, n0 = 32 * nb;
            tr_item(A.in[up ? I_WEU : I_WEG] + (size_t)e * D * EHID, EHID, n0 + (F.lane & 31), 64 * kb, WSP(bf16, WS_WGU) + (size_t)e * 1024 * D, D, 256 * (n0 >> 7) + 128 * up + (n0 & 127), scr, F.lane); }
        else { r -= 1024; const int kb = r >> 6, nb = r & 63;
            tr_item(A.in[I_WED] + (size_t)e * EHID * D, D, 32 * nb + (F.lane & 31), 64 * kb, WSP(bf16, WS_WD) + (size_t)e * D * EHID, EHID, 32 * nb, scr, F.lane); }
    }
}
__device__ __forceinline__ float dotn(const bf16* a, const bf16* b, int n8) {
    float s = 0.f;
    for (int x = 0; x < n8; ++x) { const v4u qa = *(const GAS v4u*)(a + 8 * x), kb = *(const GAS v4u*)(b + 8 * x);
        s += bflo(qa.x) * bflo(kb.x) + bfhi(qa.x) * bfhi(kb.x) + bflo(qa.y) * bflo(kb.y) + bfhi(qa.y) * bfhi(kb.y) + bflo(qa.z) * bflo(kb.z) + bfhi(qa.z) * bfhi(kb.z) + bflo(qa.w) * bflo(kb.w) + bfhi(qa.w) * bfhi(kb.w); }
    return s;
}
__device__ __forceinline__ void p8_moe_ref(Frame& F, const Args& A) {
    const bf16* x1b = WSP(bf16, WS_X1B); const bf16* wgu = WSP(bf16, WS_WGU); const bf16* wd = WSP(bf16, WS_WD); const float* asgw = WSP(float, WS_ASGW); const int* asge = WSP(int, WS_ASGE);
    bf16* hidg = WSP(bf16, WS_HID); bf16* yb = WSP(bf16, WS_YBUF);
    const int gw = F.vcu * NWAVES + F.wave, NGW = F.G * NWAVES, lane = F.lane;
    for (int a = gw; a < 2 * T; a += NGW) {
        const int t = a >> 1, e = asge[a]; const float w = asgw[a];
        const bf16* xr = x1b + (size_t)t * D; const bf16* wg = wgu + (size_t)e * 1024 * D; bf16* hrow = hidg + (size_t)a * EHID;
#pragma unroll 1
        for (int i = 0; i < 8; ++i) { const int j = lane + 64 * i; const bf16* gr = wg + (size_t)(256 * (j >> 7) + (j & 127)) * D;
            const float gv = dotn(xr, gr, 256), uv = dotn(xr, gr + (size_t)128 * D, 256); hrow[j] = (bf16)f2bf(gv * sigmoidf_(gv) * uv); }
        VM_WAIT(); __builtin_amdgcn_fence(__ATOMIC_RELEASE, "workgroup"); __builtin_amdgcn_fence(__ATOMIC_ACQUIRE, "agent");
        const bf16* wdr = wd + (size_t)e * D * EHID;
#pragma unroll 1
        for (int i = 0; i < 32; ++i) { const int col = lane + 64 * i; yb[(size_t)a * D + col] = (bf16)f2bf(w * dotn(hrow, wdr + (size_t)col * EHID, 64)); }
    }
}
__device__ __forceinline__ void p10_final(Frame& F, const Args& A) {
    const int gw = F.vcu * NWAVES + F.wave, NGW = F.G * NWAVES, lane = F.lane;
    const bf16* yb = WSP(bf16, WS_YBUF);
    const GAS f32x4* sc4 = (const GAS f32x4*)A.in[I_LN2S]; const GAS f32x4* bi4 = (const GAS f32x4*)A.in[I_LN2B];
    for (int t = gw; t < T; t += NGW) {
        GAS f32x4* xr = (GAS f32x4*)(F.out + (size_t)t * D) + lane;
        const GAS v2u* y0 = (const GAS v2u*)(yb + (size_t)(2 * t) * D) + lane; const GAS v2u* y1 = (const GAS v2u*)(yb + (size_t)(2 * t + 1) * D) + lane;
        f32x4 v[8]; float s = 0.f;
#pragma unroll
        for (int j = 0; j < 8; ++j) { const f32x4 xv = xr[64 * j]; const v2u a = y0[64 * j], b = y1[64 * j];
            v[j] = xv * ALPHA + (f32x4){bflo(a.x) + bflo(b.x), bfhi(a.x) + bfhi(b.x), bflo(a.y) + bflo(b.y), bfhi(a.y) + bfhi(b.y)};
            s += (v[j].x + v[j].y) + (v[j].z + v[j].w); }
        const float mean = wave_sum(s) * (1.f / D); float s2 = 0.f;
#pragma unroll
        for (int j = 0; j < 8; ++j) { v[j] = v[j] - mean; s2 += (v[j].x * v[j].x + v[j].y * v[j].y) + (v[j].z * v[j].z + v[j].w * v[j].w); }
        const float rstd = 1.f / sqrtf(wave_sum(s2) * (1.f / D) + LN_EPS);
#pragma unroll
        for (int j = 0; j < 8; ++j) xr[64 * j] = v[j] * rstd * sc4[lane + 64 * j] + bi4[lane + 64 * j];
    }
}
struct MoeOrder {
    const LAS int* tab; const LAS int* cnt; const int* list; int nRT, nN, G, c;
    __device__ __forceinline__ bool next(int i, pg8::Unit& u) const {
        const int L = i * G + c; if (L >= nRT * nN) return false;
        const int rt = L / nN; u.pm = rt; u.pn = L - rt * nN; const int tv = tab[rt]; u.e = tv & 255; u.lt = tv >> 8; return true;
    }
    __device__ __forceinline__ void a_rows(const pg8::Unit& u, unsigned (&v)[2][2], const int (&RA)[2], const int (&CA)[2], int K) const {
        const int n = cnt[u.e];
#pragma unroll
        for (int h = 0; h < 2; ++h)
#pragma unroll
            for (int i = 0; i < 2; ++i) { const int idx = u.lt * 256 + h * 128 + RA[i]; const int tok = (idx < n) ? (list[u.e * LCAP + idx] >> 1) : 0; v[h][i] = (unsigned)(tok * K + CA[i]) * 2u; }
    }
};
__device__ __forceinline__ int moe_tables(Frame& F) {
    LAS int* tab = (LAS int*)(F.lds + MOE_TAB_OFF); LAS int* cnt = (LAS int*)(F.lds + MOE_CNT_OFF);
    if (F.tid < NEXP) cnt[F.tid] = (int)__hip_atomic_load((unsigned*)(F.ctl + CW_CNT + 64 * F.tid), RLX_AGENT);
    __syncthreads();
    if (F.tid == 0) { int rt = 0; for (int e = 0; e < NEXP; ++e) { const int nt = (cnt[e] + 255) >> 8; for (int lt = 0; lt < nt; ++lt) tab[rt++] = e | (lt << 8); } tab[127] = rt; }
    __syncthreads();
    return tab[127];
}
struct EpiHid {
    bf16* hid;
    __device__ __forceinline__ void operator()(const f32x4 (&acc)[2][2][4][2], const pg8::Unit& u, int wr, int wc, int fr, int fq) const {
        const int row0 = u.pm * 256 + wr * 64 + fr, col = u.pn * 128 + wc * 32 + 8 * fq;
#pragma unroll
        for (int ai = 0; ai < 2; ++ai)
#pragma unroll
            for (int m = 0; m < 4; ++m) { const int row = row0 + ai * 128 + m * 16; f32x4 h0, h1;
#pragma unroll
                for (int j = 0; j < 4; ++j) { const float g0 = acc[ai][0][m][0][j], g1 = acc[ai][0][m][1][j]; h0[j] = g0 * sigmoidf_(g0) * acc[ai][1][m][0][j]; h1[j] = g1 * sigmoidf_(g1) * acc[ai][1][m][1][j]; }
                *(v4u*)(hid + (size_t)row * EHID + col) = pack8(h0, h1); }
    }
};
struct EpiY {
    bf16* yb; const int* list; const float* asgw; const LAS int* cnt;
    __device__ __forceinline__ void operator()(const f32x4 (&acc)[2][2][4][2], const pg8::Unit& u, int wr, int wc, int fr, int fq) const {
        const int n = cnt[u.e], colw = u.pn * 256 + wc * 32 + 8 * fq;
#pragma unroll
        for (int ai = 0; ai < 2; ++ai)
#pragma unroll
            for (int m = 0; m < 4; ++m) { const int idx = u.lt * 256 + ai * 128 + wr * 64 + m * 16 + fr;
                if (idx < n) { const int a = list[u.e * LCAP + idx]; const float w = asgw[a];
#pragma unroll
                    for (int bj = 0; bj < 2; ++bj) *(v4u*)(yb + (size_t)a * D + colw + bj * 128) = pack8(acc[ai][bj][m][0] * w, acc[ai][bj][m][1] * w); } }
    }
};
typedef short hx8 __attribute__((ext_vector_type(8)));
typedef short s16x4 __attribute__((ext_vector_type(4)));
typedef float f32x16 __attribute__((ext_vector_type(16)));
typedef float f32x8 __attribute__((ext_vector_type(8)));
typedef __bf16 bfv8 __attribute__((ext_vector_type(8)));
typedef __bf16 bfv4 __attribute__((ext_vector_type(4)));
#define MFMA32(a, b, c) __builtin_amdgcn_mfma_f32_32x32x16_bf16((a), (b), (c), 0, 0, 0)
constexpr float LOG2E = 1.4426950408889634f, LN2 = 0.6931471805599453f;
__device__ __forceinline__ unsigned off_b(unsigned row, unsigned ch) { return 256u * row + 16u * (ch ^ (((row & 3) << 2) | ((row >> 2) & 3))); }
__device__ __forceinline__ int crow(int reg, int hh) { return (reg & 3) + 8 * (reg >> 2) + 4 * hh; }
__device__ __forceinline__ unsigned tr_addr(int lane, int rowbase, int ct) { const int blk = (lane >> 4) & 1, q = (lane & 15) >> 2, p = lane & 3; return off_b(rowbase + q, 4 * ct + 2 * blk + (p >> 1)) + 8 * (p & 1); }
__device__ __forceinline__ hx8 tr_pair(unsigned a0, unsigned a1) { s16x4 lo, hi;
    asm volatile("ds_read_b64_tr_b16 %0, %2\n\tds_read_b64_tr_b16 %1, %3\n\ts_waitcnt lgkmcnt(0)" : "=&v"(lo), "=&v"(hi) : "v"(a0), "v"(a1) : "memory");
    return __builtin_shufflevector(lo, hi, 0, 1, 2, 3, 4, 5, 6, 7); }
__device__ __forceinline__ void tr_quad(const unsigned (&a)[8], hx8 (&o)[4]) { s16x4 r0, r1, r2, r3, r4, r5, r6, r7;
    asm volatile("ds_read_b64_tr_b16 %0, %8\n\tds_read_b64_tr_b16 %1, %9\n\tds_read_b64_tr_b16 %2, %10\n\tds_read_b64_tr_b16 %3, %11\n\tds_read_b64_tr_b16 %4, %12\n\tds_read_b64_tr_b16 %5, %13\n\tds_read_b64_tr_b16 %6, %14\n\tds_read_b64_tr_b16 %7, %15\n\ts_waitcnt lgkmcnt(0)"
        : "=&v"(r0), "=&v"(r1), "=&v"(r2), "=&v"(r3), "=&v"(r4), "=&v"(r5), "=&v"(r6), "=&v"(r7) : "v"(a[0]), "v"(a[1]), "v"(a[2]), "v"(a[3]), "v"(a[4]), "v"(a[5]), "v"(a[6]), "v"(a[7]) : "memory");
    o[0] = __builtin_shufflevector(r0, r1, 0, 1, 2, 3, 4, 5, 6, 7); o[1] = __builtin_shufflevector(r2, r3, 0, 1, 2, 3, 4, 5, 6, 7);
    o[2] = __builtin_shufflevector(r4, r5, 0, 1, 2, 3, 4, 5, 6, 7); o[3] = __builtin_shufflevector(r6, r7, 0, 1, 2, 3, 4, 5, 6, 7); }
template <int OFF> __device__ __forceinline__ void tr_quad_off(const unsigned (&a)[8], hx8 (&o)[4]) { s16x4 r0, r1, r2, r3, r4, r5, r6, r7;
    asm volatile("ds_read_b64_tr_b16 %0, %8 offset:%16\n\tds_read_b64_tr_b16 %1, %9 offset:%16\n\tds_read_b64_tr_b16 %2, %10 offset:%16\n\tds_read_b64_tr_b16 %3, %11 offset:%16\n\tds_read_b64_tr_b16 %4, %12 offset:%16\n\tds_read_b64_tr_b16 %5, %13 offset:%16\n\tds_read_b64_tr_b16 %6, %14 offset:%16\n\tds_read_b64_tr_b16 %7, %15 offset:%16\n\ts_waitcnt lgkmcnt(0)"
        : "=&v"(r0), "=&v"(r1), "=&v"(r2), "=&v"(r3), "=&v"(r4), "=&v"(r5), "=&v"(r6), "=&v"(r7) : "v"(a[0]), "v"(a[1]), "v"(a[2]), "v"(a[3]), "v"(a[4]), "v"(a[5]), "v"(a[6]), "v"(a[7]), "i"(OFF) : "memory");
    o[0] = __builtin_shufflevector(r0, r1, 0, 1, 2, 3, 4, 5, 6, 7); o[1] = __builtin_shufflevector(r2, r3, 0, 1, 2, 3, 4, 5, 6, 7);
    o[2] = __builtin_shufflevector(r4, r5, 0, 1, 2, 3, 4, 5, 6, 7); o[3] = __builtin_shufflevector(r6, r7, 0, 1, 2, 3, 4, 5, 6, 7); }
template <int S> __device__ __forceinline__ hx8 pack_step(const f32x16& x) { f32x8 v;
#pragma unroll
    for (int j = 0; j < 8; ++j) v[j] = x[8 * S + j];
    return __builtin_bit_cast(hx8, __builtin_convertvector(v, bfv8)); }
__device__ __forceinline__ v2u pack4(float a, float b, float c, float d) { typedef float f4 __attribute__((ext_vector_type(4))); const f4 v = {a, b, c, d}; return __builtin_bit_cast(v2u, __builtin_convertvector(v, bfv4)); }
__device__ __forceinline__ f32x16 zero16() { f32x16 z;
#pragma unroll
    for (int i = 0; i < 16; ++i) z[i] = 0.f;
    return z; }

__device__ __forceinline__ void p2_attn_mfma(Frame& F) {
    const bf16* proj = WSP(bf16, WS_PROJ); bf16* oag = WSP(bf16, WS_OAG); float* lse = WSP(float, WS_LSE);
    const int tid = F.tid, lane = F.lane, w = F.wave, c = lane & 31, hh = lane >> 5;
    LAS unsigned char* KI = F.lds + RING_OFF; LAS unsigned char* VI = F.lds + RING_OFF + 65536;
    const unsigned vbase = (unsigned)(uintptr_t)VI;
    for (int u = F.vcu; u < 3 * 8 * 64; u += F.G) {
        const int g = u >> 9, head = (u >> 6) & 7, nqr = u & 63;
        const int d = (g == 0) ? 1 : (g == 1 ? 4 : 16), nb = 64 / d, r = nqr / nb, nq = nqr % nb;
        const size_t hc = (size_t)(g * 8 + head) * 128;
        __syncthreads();
        {
            v4u kv[8], vv[8];
#pragma unroll
            for (int i = 0; i < 8; ++i) { const int ci = tid + 512 * i, row = ci >> 4, ch = ci & 15; const int m = 128 * (nq - 1) + row;
                if (m >= 0) { const size_t p = ((size_t)m * d + r) * NIN + hc + ch * 8; kv[i] = *(const GAS v4u*)(proj + p + C_KA); vv[i] = *(const GAS v4u*)(proj + p + C_VA); }
                else { kv[i] = (v4u){0u, 0u, 0u, 0u}; vv[i] = (v4u){0u, 0u, 0u, 0u}; } }
#pragma unroll
            for (int i = 0; i < 8; ++i) { const int ci = tid + 512 * i, row = ci >> 4, ch = ci & 15; const unsigned o = off_b(row, ch); *(LAS v4u*)(KI + o) = kv[i]; *(LAS v4u*)(VI + o) = vv[i]; }
        }
        __syncthreads();
        if (w < 4) {
            const size_t qpos = (size_t)(128 * nq + 32 * w + c) * d + r;
            hx8 qf[8];
#pragma unroll
            for (int s = 0; s < 8; ++s) qf[s] = *(const GAS hx8*)(proj + qpos * NIN + C_QA + hc + 16 * s + 8 * hh);
            f32x16 X[5]; float mx = -1e30f;
            constexpr float SC = QK_SCALE * LOG2E;
#pragma unroll
            for (int tt = 0; tt < 5; ++tt) {
                const int Tk = w + tt; const bool tv = (nq > 0) || (Tk >= 4);
                X[tt] = zero16();
                if (tv) {
#pragma unroll
                    for (int s = 0; s < 8; ++s) { const hx8 kf = *(const LAS hx8*)(KI + 8192 * Tk + off_b(c, 2 * s + hh)); X[tt] = MFMA32(kf, qf[s], X[tt]); } }
#pragma unroll
                for (int rg = 0; rg < 16; ++rg) { const int kr = crow(rg, hh); const bool ok = tv && (tt == 0 ? kr >= c : (tt == 4 ? kr <= c : true));
                    const float sv = ok ? X[tt][rg] * SC : -__builtin_inff(); X[tt][rg] = sv; mx = fmaxf(mx, sv); }
            }
            mx = fmaxf(mx, __shfl_xor(mx, 32));
            float l = 0.f;
#pragma unroll
            for (int tt = 0; tt < 5; ++tt)
#pragma unroll
                for (int rg = 0; rg < 16; ++rg) { const float pv = __builtin_amdgcn_exp2f(X[tt][rg] - mx); X[tt][rg] = pv; l += pv; }
            l += __shfl_xor(l, 32);
            f32x16 O[4];
#pragma unroll
            for (int dt = 0; dt < 4; ++dt) O[dt] = zero16();
            unsigned vb[8];
#pragma unroll
            for (int dt = 0; dt < 4; ++dt) { vb[2 * dt] = vbase + 8192u * (unsigned)w + tr_addr(lane, 4 * hh, dt); vb[2 * dt + 1] = vbase + 8192u * (unsigned)w + tr_addr(lane, 8 + 4 * hh, dt); }
#define ATT_PV(tt) do { const bool tv = (nq > 0) || (w + (tt) >= 4); if (tv) { hx8 vf[4]; \
                { const hx8 pf = pack_step<0>(X[tt]); tr_quad_off<8192 * (tt)>(vb, vf); _Pragma("unroll") for (int dt = 0; dt < 4; ++dt) O[dt] = MFMA32(vf[dt], pf, O[dt]); } \
                { const hx8 pf = pack_step<1>(X[tt]); tr_quad_off<8192 * (tt) + 4096>(vb, vf); _Pragma("unroll") for (int dt = 0; dt < 4; ++dt) O[dt] = MFMA32(vf[dt], pf, O[dt]); } } } while (0)
            ATT_PV(0); ATT_PV(1); ATT_PV(2); ATT_PV(3); ATT_PV(4);
#undef ATT_PV
            const float il = 1.f / l;
            bf16* orow = oag + ((size_t)g * T + qpos) * 1024 + head * 128 + 4 * hh;
#pragma unroll
            for (int dt = 0; dt < 4; ++dt)
#pragma unroll
                for (int rg = 0; rg < 4; ++rg) *(GAS v2u*)(orow + 32 * dt + 8 * rg) = pack4(O[dt][4 * rg] * il, O[dt][4 * rg + 1] * il, O[dt][4 * rg + 2] * il, O[dt][4 * rg + 3] * il);
            if (hh == 0) lse[((size_t)g * T + qpos) * 8 + head] = (mx + __log2f(l)) * LN2;
        }
    }
}
__device__ __forceinline__ void p2_kv_mfma(Frame& F) {
    const bf16* proj = WSP(bf16, WS_PROJ); bf16* kvT = WSP(bf16, WS_KV);
    const int tid = F.tid, lane = F.lane, w = F.wave, c = lane & 31, hh = lane >> 5;
    LAS unsigned char* KI = F.lds + RING_OFF; LAS unsigned char* VI = F.lds + RING_OFF + 32768;
    const unsigned kbase = (unsigned)(uintptr_t)KI, vbase = (unsigned)(uintptr_t)VI + 32768u * (unsigned)(w >> 2);
    for (int u = F.vcu; u < 64 * 8; u += F.G) {
        const int cc = u >> 3, h = u & 7; const float ld = logdecay(h);
        __syncthreads();
        {   v4u kv[4], vv[8];
#pragma unroll
            for (int i = 0; i < 4; ++i) { const int ci = tid + 512 * i, row = ci >> 4, ch = ci & 15; kv[i] = *(const GAS v4u*)(proj + (size_t)(cc * 128 + row) * NIN + C_KR + h * 128 + ch * 8); }
#pragma unroll
            for (int i = 0; i < 8; ++i) { const int ci = tid + 512 * i, row = ci >> 5, ch = ci & 31; vv[i] = *(const GAS v4u*)(proj + (size_t)(cc * 128 + row) * NIN + C_VR + h * 256 + ch * 8); }
#pragma unroll
            for (int i = 0; i < 4; ++i) { const int ci = tid + 512 * i, row = ci >> 4, ch = ci & 15; const float kd = __expf((float)(127 - row) * ld);
                f32x4 a, b; unpack8(kv[i], a, b); a = a * kd; b = b * kd; v4u o; o.x = pk2(a[0], a[1]); o.y = pk2(a[2], a[3]); o.z = pk2(b[0], b[1]); o.w = pk2(b[2], b[3]);
                *(LAS v4u*)(KI + off_b(row, ch)) = o; }
#pragma unroll
            for (int i = 0; i < 8; ++i) { const int ci = tid + 512 * i, row = ci >> 5, ch = ci & 31; *(LAS v4u*)(VI + 32768 * (ch >> 4) + off_b(row, ch & 15)) = vv[i]; }
        }
        __syncthreads();
        f32x16 acc[4];
#pragma unroll
        for (int dt = 0; dt < 4; ++dt) acc[dt] = zero16();
#pragma unroll 2
        for (int ks = 0; ks < 8; ++ks) {
            const hx8 vf = tr_pair(vbase + tr_addr(lane, 16 * ks + 8 * hh, w & 3), vbase + tr_addr(lane, 16 * ks + 8 * hh + 4, w & 3));
            unsigned a[8]; hx8 kf[4];
#pragma unroll
            for (int dt = 0; dt < 4; ++dt) { a[2 * dt] = kbase + tr_addr(lane, 16 * ks + 8 * hh, dt); a[2 * dt + 1] = kbase + tr_addr(lane, 16 * ks + 8 * hh + 4, dt); }
            tr_quad(a, kf);
#pragma unroll
            for (int dt = 0; dt < 4; ++dt) acc[dt] = MFMA32(kf[dt], vf, acc[dt]);
        }
        bf16* orow = kvT + ((size_t)u * 256 + 32 * w + c) * 128 + 4 * hh;
#pragma unroll
        for (int dt = 0; dt < 4; ++dt)
#pragma unroll
            for (int rg = 0; rg < 4; ++rg) *(GAS v2u*)(orow + 32 * dt + 8 * rg) = pack4(acc[dt][4 * rg], acc[dt][4 * rg + 1], acc[dt][4 * rg + 2], acc[dt][4 * rg + 3]);
    }
}
__device__ __forceinline__ void p4_ret_mfma(Frame& F) {
    const bf16* proj = WSP(bf16, WS_PROJ); const bf16* stT = WSP(bf16, WS_ST); bf16* orr = WSP(bf16, WS_OR);
    const int tid = F.tid, lane = F.lane, w = F.wave, c = lane & 31, hh = lane >> 5, nt = w & 3, eh = w >> 2;
    LAS unsigned char* KI = F.lds + RING_OFF; LAS unsigned char* VI = F.lds + RING_OFF + 32768; LAS float* ST = (LAS float*)(F.lds + RING_OFF + 98304);
    const unsigned vbase = (unsigned)(uintptr_t)VI + 32768u * (unsigned)eh;
    for (int u = F.vcu; u < 64 * 8; u += F.G) {
        const int cc = u >> 3, h = u & 7; const float ld = logdecay(h);
        __syncthreads();
        {   v4u kv[4], vv[8];
#pragma unroll
            for (int i = 0; i < 4; ++i) { const int ci = tid + 512 * i, row = ci >> 4, ch = ci & 15; kv[i] = *(const GAS v4u*)(proj + (size_t)(cc * 128 + row) * NIN + C_KR + h * 128 + ch * 8); }
#pragma unroll
            for (int i = 0; i < 8; ++i) { const int ci = tid + 512 * i, row = ci >> 5, ch = ci & 31; vv[i] = *(const GAS v4u*)(proj + (size_t)(cc * 128 + row) * NIN + C_VR + h * 256 + ch * 8); }
#pragma unroll
            for (int i = 0; i < 4; ++i) { const int ci = tid + 512 * i, row = ci >> 4, ch = ci & 15; *(LAS v4u*)(KI + off_b(row, ch)) = kv[i]; }
#pragma unroll
            for (int i = 0; i < 8; ++i) { const int ci = tid + 512 * i, row = ci >> 5, ch = ci & 31; *(LAS v4u*)(VI + 32768 * (ch >> 4) + off_b(row, ch & 15)) = vv[i]; }
        }
        __syncthreads();
        const int n = 32 * nt + c; const size_t trow = (size_t)(cc * 128 + n);
        hx8 qf[8];
#pragma unroll
        for (int s = 0; s < 8; ++s) qf[s] = *(const GAS hx8*)(proj + trow * NIN + C_QR + h * 128 + 16 * s + 8 * hh);
        f32x16 O[4];
        const float qd = __expf((float)(n + 1) * ld);
#pragma unroll
        for (int et = 0; et < 4; ++et) { O[et] = zero16(); const bf16* srow = stT + ((size_t)u * 256 + 128 * eh + 32 * et + c) * 128 + 8 * hh;
#pragma unroll
            for (int s = 0; s < 8; ++s) { const hx8 sf = *(const GAS hx8*)(srow + 16 * s); O[et] = MFMA32(sf, qf[s], O[et]); }
#pragma unroll
            for (int rg = 0; rg < 16; ++rg) O[et][rg] *= qd; }
        for (int mt = 0; mt <= nt; ++mt) {
            f32x16 X = zero16();
#pragma unroll
            for (int s = 0; s < 8; ++s) { const hx8 kf = *(const LAS hx8*)(KI + 8192 * mt + off_b(c, 2 * s + hh)); X = MFMA32(kf, qf[s], X); }
#pragma unroll
            for (int rg = 0; rg < 16; ++rg) { const int dn = 32 * (nt - mt) + c - crow(rg, hh); X[rg] = (dn >= 0) ? X[rg] * __expf((float)dn * ld) : 0.f; }
            { const hx8 pf = pack_step<0>(X); unsigned a[8]; hx8 vf[4];
#pragma unroll
              for (int et = 0; et < 4; ++et) { a[2 * et] = vbase + tr_addr(lane, 32 * mt + 4 * hh, et); a[2 * et + 1] = vbase + tr_addr(lane, 32 * mt + 8 + 4 * hh, et); }
              tr_quad(a, vf);
#pragma unroll
              for (int et = 0; et < 4; ++et) O[et] = MFMA32(vf[et], pf, O[et]); }
            { const hx8 pf = pack_step<1>(X); unsigned a[8]; hx8 vf[4];
#pragma unroll
              for (int et = 0; et < 4; ++et) { a[2 * et] = vbase + tr_addr(lane, 32 * mt + 16 + 4 * hh, et); a[2 * et + 1] = vbase + tr_addr(lane, 32 * mt + 24 + 4 * hh, et); }
              tr_quad(a, vf);
#pragma unroll
              for (int et = 0; et < 4; ++et) O[et] = MFMA32(vf[et], pf, O[et]); }
        }
        float s1 = 0.f, s2 = 0.f;
#pragma unroll
        for (int et = 0; et < 4; ++et)
#pragma unroll
            for (int rg = 0; rg < 16; ++rg) { const float x = O[et][rg]; s1 += x; s2 += x * x; }
        s1 += __shfl_xor(s1, 32); s2 += __shfl_xor(s2, 32);
        if (hh == 0) { ST[(n * 2 + eh) * 2] = s1; ST[(n * 2 + eh) * 2 + 1] = s2; }
        __syncthreads();
        const float t1 = ST[(n * 2) * 2] + ST[(n * 2 + 1) * 2], t2 = ST[(n * 2) * 2 + 1] + ST[(n * 2 + 1) * 2 + 1];
        const float mean = t1 * (1.f / 256.f), var = fmaxf(t2 * (1.f / 256.f) - mean * mean, 0.f), rstd = 1.f / sqrtf(var + LN_EPS);
        const bf16* grow = proj + trow * NIN + C_GR + h * 256 + 128 * eh + 4 * hh; bf16* orow = orr + trow * D + h * 256 + 128 * eh + 4 * hh;
#pragma unroll
        for (int et = 0; et < 4; ++et)
#pragma unroll
            for (int rg = 0; rg < 4; ++rg) { const v2u gw = *(const GAS v2u*)(grow + 32 * et + 8 * rg);
                *(GAS v2u*)(orow + 32 * et + 8 * rg) = pack4((O[et][4 * rg] - mean) * rstd * bflo(gw.x), (O[et][4 * rg + 1] - mean) * rstd * bfhi(gw.x), (O[et][4 * rg + 2] - mean) * rstd * bflo(gw.y), (O[et][4 * rg + 3] - mean) * rstd * bfhi(gw.y)); }
    }
}

constexpr int N_PHASES = 11;
__global__ void __launch_bounds__(NWAVES * 64, 2) fwd_kernel(Args args) {
    extern __shared__ __attribute__((aligned(16))) unsigned char lds[];
    Frame F;
    F.lds = (LAS unsigned char*)lds;
    F.MISC = (volatile LAS unsigned*)(F.lds + MISC_OFF);
    F.tid = threadIdx.x; F.lane = F.tid & 63; F.wave = __builtin_amdgcn_readfirstlane(F.tid >> 6);
    F.G = gridDim.x; { const int bx = blockIdx.x; F.vcu = (F.G % 8 == 0) ? (bx % 8) * (F.G / 8) + bx / 8 : bx; }
    F.ws = args.ws; F.ctl = (gu32*)(args.ws + WS_CTL); F.out = args.out;
    const Args& A = args;
    for (int u = F.tid; u < (LDS_BYTES - LDSCTL_OFF) / 4; u += NWAVES * 64) ((LAS unsigned*)(F.lds + LDSCTL_OFF))[u] = 0u;
    __syncthreads();
    XcdBarrier bar; bar.bar = (unsigned*)(F.ctl + CW_BAR); bar.x = 0; bar.st = nullptr;
    if (!MK_SPLIT) bar = xcd_barrier_post((unsigned*)(F.ctl + CW_BAR), F.MISC + 8);
    const int lo = args.ph_lo, hi = args.ph_hi;
#ifndef PH_MASK
#define PH_MASK 0xFFFF
#endif
#define IN(k) (((PH_MASK >> (k)) & 1) && lo <= (k) && (k) < hi)
#define SEAM(k) do { if (IN(k) && IN((k) + 1)) xcd_barrier(bar); } while (0)

    if (IN(0)) { p0_prologue(F, A); } SEAM(0);
    if (IN(1)) {
        pg8::Gemm g{WSP(bf16, WS_XB), WSP(bf16, WS_WINT), D, 0}; pg8::StaticOrder S; S.init(T, NIN, F.G, (int)blockIdx.x);
        EpiProj E{WSP(bf16, WS_PROJ), WSP(float, WS_COSA), WSP(float, WS_SINA), WSP(float, WS_COSR), WSP(float, WS_SINR)};
        pg8::gemm_phase<EpiProj, pg8::StaticOrder, true, false>(F.lds + RING_OFF, g, S, E);
    } SEAM(1);
    #ifndef USE_REF
#define USE_REF 0
#endif
    if (IN(2)) { if (USE_REF & 1) p2_attn_ref(F, A); else p2_attn_mfma(F); if (USE_REF & 2) p2_kv_ref(F, A); else p2_kv_mfma(F); } SEAM(2);
    if (IN(3)) { p3_scan_combine(F, A); } SEAM(3);
    if (IN(4)) { if (USE_REF & 4) p4_ret_ref(F, A); else p4_ret_mfma(F); } SEAM(4);
    if (IN(5)) {
        { pg8::Gemm g{WSP(bf16, WS_OA), WSP(bf16, WS_WAT), 1024, 0}; pg8::StaticOrder S; S.init(T, D, F.G, (int)blockIdx.x);
          EpiTmp E{WSP(float, WS_TMP), WSP(bf16, WS_PROJ)};
          pg8::gemm_phase<EpiTmp, pg8::StaticOrder, true, false>(F.lds + RING_OFF, g, S, E); }
        { pg8::Gemm g{WSP(bf16, WS_OR), WSP(bf16, WS_WRT), 2048, 0}; pg8::StaticOrder S; S.init(T, D, F.G, (int)blockIdx.x);
          EpiMerged E{WSP(float, WS_TMP), WSP(bf16, WS_PROJ), WSP(bf16, WS_MERGED)};
          pg8::gemm_phase<EpiMerged, pg8::StaticOrder, true, false>(F.lds + RING_OFF, g, S, E); }
    } SEAM(5);
    if (IN(6)) {
        pg8::Gemm g{WSP(bf16, WS_MERGED), WSP(bf16, WS_WOT), 2048, 0}; pg8::StaticOrder S; S.init(T, D, F.G, (int)blockIdx.x);
        EpiR1 E{A.in[I_X], F.out};
        pg8::gemm_phase<EpiR1, pg8::StaticOrder, true, false>(F.lds + RING_OFF, g, S, E);
    } SEAM(6);
    if (IN(7)) { p7_ln_router(F, A); p7_expert_weights(F, A); } SEAM(7);
    if (IN(8)) {
        const int nRT = moe_tables(F);
        pg8::Gemm g{WSP(bf16, WS_X1B), WSP(bf16, WS_WGU), 2048, (size_t)1024 * D * 2};
        MoeOrder S{(const LAS int*)(F.lds + MOE_TAB_OFF), (const LAS int*)(F.lds + MOE_CNT_OFF), WSP(int, WS_LIST), nRT, 4, F.G, (int)blockIdx.x};
        EpiHid E{WSP(bf16, WS_HID)};
        pg8::gemm_phase<EpiHid, MoeOrder, true, true>(F.lds + RING_OFF, g, S, E);
    } SEAM(8);
    if (IN(9)) {
        const int nRT = moe_tables(F);
        pg8::Gemm g{WSP(bf16, WS_HID), WSP(bf16, WS_WD), EHID, (size_t)D * EHID * 2};
        MoeOrder S{(const LAS int*)(F.lds + MOE_TAB_OFF), (const LAS int*)(F.lds + MOE_CNT_OFF), WSP(int, WS_LIST), nRT, 8, F.G, (int)blockIdx.x};
        EpiY E{WSP(bf16, WS_YBUF), WSP(int, WS_LIST), WSP(float, WS_ASGW), (const LAS int*)(F.lds + MOE_CNT_OFF)};
        pg8::gemm_phase<EpiY, MoeOrder, true, false>(F.lds + RING_OFF, g, S, E);
    } SEAM(9);
    if (IN(10)) { p10_final(F, A); }
#undef IN
#undef SEAM
}

extern "C" void kernel_launch(void* const* d_in, const int* in_sizes, int n_in, void* d_out, int out_size, void* d_ws, size_t ws_size, hipStream_t stream) {
    static int grid = 0;
    if (grid == 0) {
        if (n_in != 17 || in_sizes[0] != T * D || out_size != T * D || ws_size < WS_END) { fprintf(stderr, "kernel_launch: unexpected shapes (n_in %d, in0 %d, out %d, ws %zu < %zu); nothing launched\n", n_in, n_in > 0 ? in_sizes[0] : -1, out_size, ws_size, (size_t)WS_END); grid = -1; return; }
        int dev = 0, cus = 0, per_cu = 0;
        if (hipGetDevice(&dev) != hipSuccess || hipDeviceGetAttribute(&cus, hipDeviceAttributeMultiprocessorCount, dev) != hipSuccess) { grid = -1; return; }
        if (hipFuncSetAttribute((const void*)fwd_kernel, hipFuncAttributeMaxDynamicSharedMemorySize, LDS_BYTES) != hipSuccess) { fprintf(stderr, "kernel_launch: hipFuncSetAttribute failed\n"); grid = -1; return; }
        if (hipOccupancyMaxActiveBlocksPerMultiprocessor(&per_cu, (const void*)fwd_kernel, NWAVES * 64, LDS_BYTES) != hipSuccess || per_cu < 1)
            fprintf(stderr, "kernel_launch: note: occupancy query reports %d workgroups per CU\n", per_cu);
        (void)hipGetLastError();
        grid = cus;
    }
    if (grid < 0) return;
    if (hipMemsetAsync((char*)d_ws + WS_CTL, 0, CTL_ZERO_BYTES, stream) != hipSuccess) return;
    Args a{};
    for (int i = 0; i < 17; ++i) a.in[i] = (const float*)d_in[i];
    a.out = (float*)d_out; a.ws = (unsigned char*)d_ws;
#if MK_SPLIT
    for (int p = 0; p < N_PHASES; ++p) { a.ph_lo = p; a.ph_hi = p + 1; hipLaunchKernelGGL(fwd_kernel, dim3(grid), dim3(NWAVES * 64), LDS_BYTES, stream, a); }
#else
    a.ph_lo = 0; a.ph_hi = N_PHASES;
    hipLaunchKernelGGL(fwd_kernel, dim3(grid), dim3(NWAVES * 64), LDS_BYTES, stream, a);
#endif
    const hipError_t le = hipPeekAtLastError();
    if (le != hipSuccess) fprintf(stderr, "kernel_launch: launch failed: %s\n", hipGetErrorName(le));
}
```

```cpp
#include <hip/hip_runtime.h>
#include <cstdio>
#include <cstdint>
#ifndef MK_SPLIT
#define MK_SPLIT 0
#endif
namespace pg8 {
#define PG8_LAS __attribute__((address_space(3)))
typedef unsigned short bf16_t;
typedef short bf16x8 __attribute__((ext_vector_type(8)));
typedef float f32x4 __attribute__((ext_vector_type(4)));
typedef unsigned u32x4 __attribute__((ext_vector_type(4)));
constexpr int BM = 256, BK = 64, HALF = 128, HTB = HALF * BK * 2  , STAGE_BYTES = 8 * HTB, NXCD = 8, WGM = 8;

__host__ __device__ __forceinline__ int lds_byte(int r, int c) { const int st = (r >> 4) * 2 + (c >> 5), rr = r & 15, cc = c & 31, ob = rr * 64 + cc * 2; return st * 1024 + (ob ^ (((ob >> 9) & 1) << 5)); }
__host__ __device__ __forceinline__ void stage_rc(int b, int& R, int& C) { const int st = b / 1024, sb = b % 1024, swz = sb ^ (((sb >> 9) & 1) << 5); R = (st >> 1) * 16 + swz / 64; C = (st & 1) * 32 + (swz % 64) / 2; }
__host__ __device__ __forceinline__ int perm32(int rho) { const int n = rho >> 4, i = rho & 15; return 8 * (i >> 2) + 4 * n + (i & 3); }

struct Unit { int pm, pn, e, lt; };
struct Gemm { const bf16_t* A; const bf16_t* Bt; int K; size_t bstride; };

struct StaticOrder {
    int nM, nN, nwg, G, c;
    __host__ __device__ void init(int M, int N, int G_, int c_) { nM = M / BM; nN = N / BM; nwg = nM * nN; G = G_; c = c_; }
    __host__ __device__ bool next(int i, Unit& u) const {
        const long L = (long)i * G + c; if (L >= nwg) return false;
        int wgid = (int)L; { const int q = nwg / NXCD, r = nwg % NXCD, xcd = wgid % NXCD, off = wgid / NXCD; wgid = (xcd < r ? xcd * (q + 1) : r * (q + 1) + (xcd - r) * q) + off; }
        const int nig = WGM * nN, gid = wgid / nig, fm = gid * WGM, gsz = (nM - fm) < WGM ? (nM - fm) : WGM;
        u.pm = fm + ((wgid % nig) % gsz); u.pn = (wgid % nig) / gsz; u.e = 0; u.lt = 0; return true;
    }
    __device__ __forceinline__ void a_rows(const Unit&, unsigned (&)[2][2], const int (&)[2], const int (&)[2], int) const {}
};
__device__ __forceinline__ unsigned cvt_pk_bf16(float lo, float hi) { unsigned r; asm volatile("v_cvt_pk_bf16_f32 %0, %1, %2" : "=v"(r) : "v"(lo), "v"(hi)); return r; }

template <class Epi, class Sched, bool ALIGN_EPI, bool GATHER>
__device__ __forceinline__ void gemm_phase(PG8_LAS unsigned char* lds, const Gemm g, const Sched& S, const Epi& E) {
    const int tid = threadIdx.x, wid = __builtin_amdgcn_readfirstlane(tid >> 6), lane = tid & 63, wr = wid >> 2, wc = wid & 3, fr = lane & 15, fq = lane >> 4;
    const int K = g.K, nt = K / BK;
    const size_t kstep = (size_t)(BK * 2);
    const size_t hstep = (size_t)HALF * K * 2;
    const size_t tstep = 2 * hstep;
    unsigned voffB[2], vA[2][2], vAn[2][2]; int RA[2], CA[2];
#pragma unroll
    for (int i = 0; i < 2; ++i) { int R, C; stage_rc(tid * 16 + i * 8192, R, C); const int Rb = (R & ~31) + perm32(R & 31);
        RA[i] = R; CA[i] = C; voffB[i] = (unsigned)(Rb * K + C) * 2u;
        vA[0][i] = (unsigned)(R * K + C) * 2u; vA[1][i] = vA[0][i] + (unsigned)hstep; vAn[0][i] = vA[0][i]; vAn[1][i] = vA[1][i]; }
    const unsigned ldsw = (unsigned)wid * 1024u;
    const int aoff = lds_byte(wr * 64 + fr, fq * 8), boff = lds_byte(wc * 32 + fr, fq * 8);
#define PG8_SA(b, h) (((b) * 2 + (h)) * HTB)
#define PG8_SB(b, h) ((4 + (b) * 2 + (h)) * HTB)
#define PG8_STAGE(bufoff, gbase, voff) do { _Pragma("unroll") for (int _i = 0; _i < 2; ++_i) \
        __builtin_amdgcn_global_load_lds((const unsigned*)((const char*)(gbase) + (voff)[_i]), (PG8_LAS unsigned*)(lds + (bufoff) + ldsw + _i * 8192), 16, 0, 0); } while (0)
#define PG8_LDA(dst, b, h) do { _Pragma("unroll") for (int m = 0; m < 4; ++m) _Pragma("unroll") for (int k = 0; k < 2; ++k) dst[m][k] = *(const PG8_LAS bf16x8*)(lds + PG8_SA(b, h) + aoff + m * 2048 + k * 1024); } while (0)
#define PG8_LDB(dst, b, h) do { _Pragma("unroll") for (int n = 0; n < 2; ++n) _Pragma("unroll") for (int k = 0; k < 2; ++k) dst[n][k] = *(const PG8_LAS bf16x8*)(lds + PG8_SB(b, h) + boff + n * 2048 + k * 1024); } while (0)
#define PG8_MMA(ai, bj, At, Bt) do { __builtin_amdgcn_s_setprio(1); _Pragma("unroll") for (int m = 0; m < 4; ++m) _Pragma("unroll") for (int n = 0; n < 2; ++n) _Pragma("unroll") for (int k = 0; k < 2; ++k) \
        acc[ai][bj][m][n] = __builtin_amdgcn_mfma_f32_16x16x32_bf16(Bt[n][k], At[m][k], acc[ai][bj][m][n], 0, 0, 0); __builtin_amdgcn_s_setprio(0); } while (0)
#define PG8_WAIT_V(n) asm volatile("s_waitcnt vmcnt(" #n ")" ::: "memory")
#define PG8_WAIT_L(n) asm volatile("s_waitcnt lgkmcnt(" #n ")" ::: "memory")
#define PG8_BAR __builtin_amdgcn_s_barrier()
#define PG8_SCHED __builtin_amdgcn_sched_barrier(0)
    Unit cur, nxt; int ui = 0;
    if (!S.next(0, cur)) return;
    f32x4 acc[2][2][4][2];
#pragma unroll
    for (int a = 0; a < 2; ++a)
#pragma unroll
        for (int b = 0; b < 2; ++b)
#pragma unroll
            for (int m = 0; m < 4; ++m)
#pragma unroll
                for (int n = 0; n < 2; ++n) acc[a][b][m][n] = (f32x4){0.f, 0.f, 0.f, 0.f};
    bf16x8 At[4][2], B0[2][2], B1[2][2];
    const char* cA = (const char*)g.A + (GATHER ? (size_t)0 : (size_t)cur.pm * tstep);
    const char* cB = (const char*)g.Bt + (size_t)cur.e * g.bstride + (size_t)cur.pn * tstep;
    if constexpr (GATHER) S.a_rows(cur, vA, RA, CA, K);
    PG8_STAGE(PG8_SB(0, 0), cB, voffB); PG8_STAGE(PG8_SB(0, 1), cB + hstep, voffB); PG8_STAGE(PG8_SA(0, 0), cA, vA[0]); PG8_STAGE(PG8_SA(0, 1), cA, vA[1]);
    if (wr == 1) PG8_BAR;
    PG8_WAIT_V(2); PG8_BAR;
    PG8_STAGE(PG8_SB(1, 0), cB + kstep, voffB); PG8_STAGE(PG8_SA(1, 0), cA + kstep, vA[0]); PG8_STAGE(PG8_SB(1, 1), cB + hstep + kstep, voffB);
    PG8_WAIT_V(6); PG8_BAR;
    for (;;) {
        const bool has_next = S.next(ui + 1, nxt);
        const char* nA = has_next ? (const char*)g.A + (GATHER ? (size_t)0 : (size_t)nxt.pm * tstep) : cA;
        const char* nB = has_next ? (const char*)g.Bt + (size_t)nxt.e * g.bstride + (size_t)nxt.pn * tstep : cB;
        if constexpr (GATHER) { if (has_next) S.a_rows(nxt, vAn, RA, CA, K); }
        for (int t = 0; t < nt; t += 2) {
            const bool last = (t == nt - 2);
            const char* a1 = cA + (size_t)(t + 1) * kstep;
            const char* a2 = last ? nA : cA + (size_t)(t + 2) * kstep; const char* b2 = last ? nB : cB + (size_t)(t + 2) * kstep;
            const char* a3 = a2 + kstep; const char* b3 = b2 + kstep;
            unsigned vX[2][2];
#pragma unroll
            for (int h = 0; h < 2; ++h)
#pragma unroll
                for (int i = 0; i < 2; ++i) vX[h][i] = (GATHER && last) ? vAn[h][i] : vA[h][i];
            PG8_LDB(B0, 0, 0); PG8_LDB(B1, 0, 1); PG8_SCHED; PG8_LDA(At, 0, 0); PG8_STAGE(PG8_SA(1, 1), a1, vA[1]);
            PG8_WAIT_V(8); PG8_WAIT_L(0); PG8_BAR; PG8_MMA(0, 0, At, B0); PG8_MMA(0, 1, At, B1); PG8_BAR; PG8_SCHED;
            PG8_LDA(At, 0, 1); PG8_STAGE(PG8_SB(0, 0), b2, voffB); PG8_STAGE(PG8_SB(0, 1), b2 + hstep, voffB); PG8_STAGE(PG8_SA(0, 0), a2, vX[0]);
            PG8_WAIT_V(8); PG8_WAIT_L(0); PG8_BAR; PG8_MMA(1, 0, At, B0); PG8_MMA(1, 1, At, B1); PG8_BAR; PG8_SCHED;
            PG8_LDB(B0, 1, 0); PG8_LDB(B1, 1, 1); PG8_SCHED; PG8_LDA(At, 1, 0); PG8_STAGE(PG8_SA(0, 1), a2, vX[1]);
            PG8_WAIT_V(8); PG8_WAIT_L(0); PG8_BAR; PG8_MMA(0, 0, At, B0); PG8_MMA(0, 1, At, B1); PG8_BAR; PG8_SCHED;
            PG8_LDA(At, 1, 1); PG8_STAGE(PG8_SB(1, 0), b3, voffB); PG8_STAGE(PG8_SB(1, 1), b3 + hstep, voffB); PG8_STAGE(PG8_SA(1, 0), a3, vX[0]);
            PG8_WAIT_V(8); PG8_WAIT_L(0); PG8_BAR; PG8_MMA(1, 0, At, B0); PG8_MMA(1, 1, At, B1); PG8_BAR; PG8_SCHED;
        }
        if constexpr (ALIGN_EPI) { if (wr == 0) PG8_BAR; }
        E(acc, cur, wr, wc, fr, fq);
        if (!has_next) break;
#pragma unroll
        for (int a = 0; a < 2; ++a)
#pragma unroll
            for (int b = 0; b < 2; ++b)
#pragma unroll
                for (int m = 0; m < 4; ++m)
#pragma unroll
                    for (int n = 0; n < 2; ++n) acc[a][b][m][n] = (f32x4){0.f, 0.f, 0.f, 0.f};
        cur = nxt; cA = nA; cB = nB; ++ui;
        if constexpr (GATHER) {
#pragma unroll
            for (int h = 0; h < 2; ++h)
#pragma unroll
                for (int i = 0; i < 2; ++i) vA[h][i] = vAn[h][i]; }
        if constexpr (ALIGN_EPI) { if (wr == 1) PG8_BAR; }
    }
    PG8_WAIT_V(0);
    if constexpr (!ALIGN_EPI) { if (wr == 0) PG8_BAR; }
    PG8_BAR;
#undef PG8_SA
#undef PG8_SB
#undef PG8_STAGE
#undef PG8_LDA
#undef PG8_LDB
#undef PG8_MMA
#undef PG8_WAIT_V
#undef PG8_WAIT_L
#undef PG8_BAR
#undef PG8_SCHED
}
}

constexpr int T = 8192, D = 2048, NIN = 19456;
constexpr int C_QA = 0, C_KA = 3072, C_VA = 6144, C_QR = 9216, C_KR = 10240, C_VR = 11264, C_GR = 13312, C_GA = 15360, C_GB = 17408;
constexpr int NEXP = 32, EHID = 512, LCAP = 8192;
constexpr float ALPHA = 1.189207115002721f;
constexpr float LN_EPS = 1e-5f;
constexpr float QK_SCALE = 0.08838834764831845f;
constexpr int NWAVES = 8;
constexpr size_t MiB = 1u << 20;
constexpr size_t WS_CTL = 0, CTL_ZERO_BYTES = 1 * MiB;
constexpr size_t WS_COSA = 1 * MiB, WS_SINA = WS_COSA + 512 * 1024, WS_COSR = 2 * MiB, WS_SINR = 4 * MiB;
constexpr size_t WS_ASGW = 6 * MiB, WS_ASGE = WS_ASGW + 64 * 1024, WS_LIST = WS_ASGW + 256 * 1024;
constexpr size_t WS_LSE = 7 * MiB + 512 * 1024;
constexpr size_t WS_WAT = 10 * MiB, WS_WRT = 14 * MiB, WS_WOT = 22 * MiB;
constexpr size_t WS_XB = 30 * MiB, WS_WINT = 62 * MiB;
constexpr size_t WS_PROJ = 138 * MiB;
constexpr size_t WS_OAG = 30 * MiB, WS_KV = 78 * MiB, WS_OA = 110 * MiB;
constexpr size_t WS_ST = 442 * MiB, WS_OR = 474 * MiB, WS_TMP = 506 * MiB, WS_MERGED = 570 * MiB;
constexpr size_t WS_WGU = 138 * MiB, WS_WD = 266 * MiB, WS_X1B = 330 * MiB, WS_HID = 362 * MiB, WS_YBUF = 386 * MiB;
constexpr size_t WS_END = 602 * MiB;
constexpr int CW_BAR = 4096;
constexpr int CW_CNT = 16384;
constexpr int RING_OFF = 0, RING_BYTES = 131072;
constexpr int LDSCTL_OFF = RING_BYTES, MISC_OFF = LDSCTL_OFF + 320;
constexpr int MOE_TAB_OFF = RING_BYTES + 1024, MOE_CNT_OFF = MOE_TAB_OFF + 512;
constexpr int LDS_BYTES = 147456;

#define GAS __attribute__((address_space(1)))
#define LAS __attribute__((address_space(3)))
typedef unsigned short bf16;
typedef unsigned v4u __attribute__((ext_vector_type(4)));
typedef unsigned v2u __attribute__((ext_vector_type(2)));
typedef float f32x4 __attribute__((ext_vector_type(4)));
typedef GAS unsigned gu32;
#define RLX_AGENT __ATOMIC_RELAXED, __HIP_MEMORY_SCOPE_AGENT
#define LDS_WAIT() asm volatile("s_waitcnt lgkmcnt(0)" ::: "memory")
#define VM_WAIT() asm volatile("s_waitcnt vmcnt(0)" ::: "memory")
__device__ __forceinline__ unsigned f2bf(float f) { unsigned u = __builtin_bit_cast(unsigned, f); return (u + 0x7fffu + ((u >> 16) & 1u)) >> 16; }
__device__ __forceinline__ unsigned pk2(float lo, float hi) { return f2bf(lo) | (f2bf(hi) << 16); }
__device__ __forceinline__ float bflo(unsigned w) { return __builtin_bit_cast(float, w << 16); }
__device__ __forceinline__ float bfhi(unsigned w) { return __builtin_bit_cast(float, w & 0xffff0000u); }
__device__ __forceinline__ float bf2f(bf16 b) { return __builtin_bit_cast(float, (unsigned)b << 16); }
__device__ __forceinline__ float wave_sum(float v) {
#pragma unroll
    for (int o = 1; o < 64; o <<= 1) v += __shfl_xor(v, o);
    return v;
}
__device__ __forceinline__ float wave_max(float v) {
#pragma unroll
    for (int o = 1; o < 64; o <<= 1) v = fmaxf(v, __shfl_xor(v, o));
    return v;
}
__device__ __forceinline__ float sigmoidf_(float x) { return 1.f / (1.f + __expf(-x)); }

#define XB_TMO      128
#define XB_XCNT(j)  (256  + 64 * (j))
#define XB_XSUB(j)  (1280 + 64 * (j))
#define XB_XGEN(j)  (2304 + 64 * (j))
#define XB_TOP      3328
#define XB_TOPGEN   3392
#define XCD_BAR_WORDS 3456
#define XB_SPIN_CAP (1u << 18)

__device__ __forceinline__ unsigned xb_ld(unsigned* p)              { return __hip_atomic_load(p, __ATOMIC_RELAXED, __HIP_MEMORY_SCOPE_AGENT); }
__device__ __forceinline__ unsigned xb_add(unsigned* p, unsigned v) { return __hip_atomic_fetch_add(p, v, __ATOMIC_RELAXED, __HIP_MEMORY_SCOPE_AGENT); }
__device__ __forceinline__ unsigned xb_xcc_id() { return (unsigned)__builtin_amdgcn_s_getreg((3 << 11) | 20) & 0xFu; }
#define XB_SPIN(cond, bar) do { unsigned _sp = 0; while (cond) { __builtin_amdgcn_s_sleep(1); \
    if ((++_sp & 255u) == 0u) { if (xb_ld(&(bar)[XB_TMO])) break; if (_sp > XB_SPIN_CAP) { atomicAdd(&(bar)[XB_TMO], 1u); break; } } } } while (0)

struct XcdBarrier {
    unsigned* bar; unsigned x;
    volatile LAS unsigned* st;
};

__device__ __forceinline__ XcdBarrier xcd_barrier_post(unsigned* bar, volatile LAS unsigned* st) {
    XcdBarrier b; b.bar = bar; b.x = xb_xcc_id(); b.st = st;
    if (threadIdx.x == 0) (void)xb_add(&bar[XB_XCNT(b.x)], 1u);
    return b;
}
__device__ __forceinline__ void xcd_barrier_complete(unsigned* bar, unsigned x, unsigned& nloc, unsigned& nx) {
    const unsigned G = gridDim.x * gridDim.y * gridDim.z;
    unsigned sum, cnt, mine, sp = 0u;
    for (;;) {
        sum = 0u; cnt = 0u; mine = 0u;
#pragma unroll
        for (unsigned j = 0; j < 16; ++j) { const unsigned c = xb_ld(&bar[XB_XCNT(j)]); sum += c; cnt += (c > 0u) ? 1u : 0u; mine = (j == x) ? c : mine; }
        if (sum == G) break;
        __builtin_amdgcn_s_sleep(1);
        if ((++sp & 255u) == 0u) { if (xb_ld(&bar[XB_TMO])) break; if (sp > XB_SPIN_CAP) { atomicAdd(&bar[XB_TMO], 1u); break; } }
    }
    nloc = mine > 0u ? mine : 1u; nx = cnt > 0u ? cnt : 1u;
}

__device__ __forceinline__ void xcd_barrier(const XcdBarrier& b) {
    asm volatile("s_waitcnt vmcnt(0)" ::: "memory");
    __syncthreads();
    if (threadIdx.x == 0) {
        unsigned* bar = b.bar;
        __builtin_amdgcn_s_waitcnt(0);
        unsigned nloc = b.st[0], nx = b.st[1];
        if (nloc == 0u) { xcd_barrier_complete(bar, b.x, nloc, nx); b.st[0] = nloc; b.st[1] = nx; }
        const unsigned old = xb_add(&bar[XB_XSUB(b.x)], 1u);
        const unsigned gen = old / nloc;
        if (old + 1u == (gen + 1u) * nloc) {
            __builtin_amdgcn_fence(__ATOMIC_RELEASE, "agent");
            asm volatile("s_waitcnt vmcnt(0)" ::: "memory");
            const unsigned og = xb_add(&bar[XB_TOP], 1u);
            const unsigned tg = og / nx;
            if (og + 1u == (tg + 1u) * nx) xb_add(&bar[XB_TOPGEN], 1u);
            else XB_SPIN(xb_ld(&bar[XB_TOPGEN]) == tg, bar);
            __builtin_amdgcn_fence(__ATOMIC_ACQUIRE, "agent");
            xb_add(&bar[XB_XGEN(b.x)], 1u);
            asm volatile("s_waitcnt vmcnt(0)" ::: "memory");
        } else {
            XB_SPIN(xb_ld(&bar[XB_XGEN(b.x)]) == gen, bar);
            __builtin_amdgcn_fence(__ATOMIC_ACQUIRE, "agent");
            asm volatile("s_waitcnt vmcnt(0)" ::: "memory");
        }
    }
    __syncthreads();
}

struct Frame {
    LAS unsigned char* lds;
    volatile LAS unsigned* MISC;
    gu32* ctl;
    int tid, lane, wave;
    int vcu, G;
    float* out; unsigned char* ws;
};
struct Args { const float* in[17]; float* out; unsigned char* ws; int ph_lo, ph_hi; };
#define WSP(type, off) ((type*)(F.ws + (off)))
enum { I_X = 0, I_POS, I_WIN, I_WBA, I_WBR, I_WOUT, I_LN1S, I_LN1B, I_WGR, I_BGR, I_WER, I_BER, I_WEG, I_WEU, I_WED, I_LN2S, I_LN2B };

__device__ __forceinline__ float logdecay(int h) { return log1pf(-exp2f(-5.f - (float)h)); }

__device__ __forceinline__ int win_src_col(int n) {
    if (n < C_VA) { int j = n & 127; if (j < 32) j = ((j & 1) << 4) + (j >> 1); return (n & ~127) + j; }
    if (n >= C_QR && n < C_VR) { int j = n & 127; j = ((j & 1) << 6) + (j >> 1); return (n & ~127) + j; }
    return n;
}
__device__ __forceinline__ void tr_item(const float* W, size_t ldw, int sc, int k0, bf16* WT, size_t ldt, int dr0, LAS float* scr, int lane) {
#pragma unroll 8
    for (int i = 0; i < 32; ++i) { const int kk = 2 * i + (lane >> 5); scr[kk * 33 + (lane & 31)] = W[(size_t)(k0 + kk) * ldw + sc]; }
    LDS_WAIT(); asm volatile("" ::: "memory");
    const int c = lane & 7;
#pragma unroll
    for (int j = 0; j < 4; ++j) { const int n = (lane >> 3) + 8 * j; const LAS float* s = scr + (8 * c) * 33 + n;
        v4u o; o.x = pk2(s[0 * 33], s[1 * 33]); o.y = pk2(s[2 * 33], s[3 * 33]); o.z = pk2(s[4 * 33], s[5 * 33]); o.w = pk2(s[6 * 33], s[7 * 33]);
        *(GAS v4u*)(WT + (size_t)(dr0 + n) * ldt + k0 + 8 * c) = o; }
    LDS_WAIT(); asm volatile("" ::: "memory");
}
__device__ __forceinline__ void p0_prologue(Frame& F, const Args& A) {
    LAS float* scr = (LAS float*)(F.lds + RING_OFF + F.wave * 16384);
    const int gw = F.vcu * NWAVES + F.wave, NGW = F.G * NWAVES;
    constexpr int I_IN = 32 * 608, I_A = 16 * 64, I_R = 32 * 64, I_O = 32 * 64, NITEMS = I_IN + I_A + I_R + I_O;
    for (int it = gw; it < NITEMS; it += NGW) {
        int r = it;
        if (r < I_IN) { const int kb = r / 608, nb = r % 608; tr_item(A.in[I_WIN], NIN, win_src_col(32 * nb + (F.lane & 31)), 64 * kb, WSP(bf16, WS_WINT), D, 32 * nb, scr, F.lane); continue; } r -= I_IN;
        if (r < I_A) { const int kb = r / 64, nb = r % 64; tr_item(A.in[I_WBA], D, 32 * nb + (F.lane & 31), 64 * kb, WSP(bf16, WS_WAT), 1024, 32 * nb, scr, F.lane); continue; } r -= I_A;
        if (r < I_R) { const int kb = r / 64, nb = r % 64; tr_item(A.in[I_WBR], D, 32 * nb + (F.lane & 31), 64 * kb, WSP(bf16, WS_WRT), 2048, 32 * nb, scr, F.lane); continue; } r -= I_R;
        { const int kb = r / 64, nb = r % 64; tr_item(A.in[I_WOUT], D, 32 * nb + (F.lane & 31), 64 * kb, WSP(bf16, WS_WOT), 2048, 32 * nb, scr, F.lane); }
    }
    const int gt = F.vcu * 512 + F.tid, NGT = F.G * 512;
    { const GAS f32x4* x4 = (const GAS f32x4*)A.in[I_X]; GAS v4u* xb = (GAS v4u*)WSP(bf16, WS_XB);
      for (int i = gt; i < T * D / 8; i += NGT) { const f32x4 a = x4[2 * i], b = x4[2 * i + 1]; v4u o; o.x = pk2(a.x, a.y); o.y = pk2(a.z, a.w); o.z = pk2(b.x, b.y); o.w = pk2(b.z, b.w); xb[i] = o; } }
    { const int* pos = (const int*)A.in[I_POS]; float* cA = WSP(float, WS_COSA); float* sA = WSP(float, WS_SINA); float* cR = WSP(float, WS_COSR); float* sR = WSP(float, WS_SINR);
      for (int i = gt; i < T * 80; i += NGT) { const int t = i / 80, j = i % 80;
        const double inv = (j < 16) ? exp(-((double)(2 * j) / 32.0) * 13.122363377404328)   : exp(-((double)(j - 16) / 63.0) * 9.210340371976184)  ;
        const double a = (double)pos[t] * inv, n = rint(a * 0.15915494309189535), r = a - n * 6.283185307179586;
        const float c = cosf((float)r), s = sinf((float)r);
        if (j < 16) { cA[t * 16 + j] = c; sA[t * 16 + j] = s; } else { cR[t * 64 + j - 16] = c; sR[t * 64 + j - 16] = s; } } }
}
#define EPI_LOOP_BEGIN const int row0 = u.pm * 256 + wr * 64 + fr; const int colw = wc * 32 + 8 * fq; \
    _Pragma("unroll") for (int ai = 0; ai < 2; ++ai) _Pragma("unroll") for (int m = 0; m < 4; ++m) { const int row = row0 + ai * 128 + m * 16; \
    _Pragma("unroll") for (int bj = 0; bj < 2; ++bj) { f32x4 v0 = acc[ai][bj][m][0], v1 = acc[ai][bj][m][1]; const int col = u.pn * 256 + bj * 128 + colw;
#define EPI_LOOP_END } }
__device__ __forceinline__ v4u pack8(const f32x4& v0, const f32x4& v1) { v4u w; w.x = pg8::cvt_pk_bf16(v0[0], v0[1]); w.y = pg8::cvt_pk_bf16(v0[2], v0[3]); w.z = pg8::cvt_pk_bf16(v1[0], v1[1]); w.w = pg8::cvt_pk_bf16(v1[2], v1[3]); return w; }
__device__ __forceinline__ void unpack8(const v4u w, f32x4& a, f32x4& b) { a = (f32x4){bflo(w.x), bfhi(w.x), bflo(w.y), bfhi(w.y)}; b = (f32x4){bflo(w.z), bfhi(w.z), bflo(w.w), bfhi(w.w)}; }
__device__ __forceinline__ void rot8(f32x4& v0, f32x4& v1, const f32x4 c, const f32x4 s) {
    float a, b;
    a = v0[0]; b = v0[1]; v0[0] = a * c[0] - b * s[0]; v0[1] = b * c[0] + a * s[0];
    a = v0[2]; b = v0[3]; v0[2] = a * c[1] - b * s[1]; v0[3] = b * c[1] + a * s[1];
    a = v1[0]; b = v1[1]; v1[0] = a * c[2] - b * s[2]; v1[1] = b * c[2] + a * s[2];
    a = v1[2]; b = v1[3]; v1[2] = a * c[3] - b * s[3]; v1[3] = b * c[3] + a * s[3];
}
struct EpiProj {
    bf16* O; const float *cosA, *sinA, *cosR, *sinR;
    __device__ __forceinline__ void operator()(const f32x4 (&acc)[2][2][4][2], const pg8::Unit& u, int wr, int wc, int fr, int fq) const {
        const int colt = u.pn * 256;
        int kind = 0;
        if (colt < C_VA) kind = 1; else if (colt < C_QR) kind = 0; else if (colt < C_KR) kind = 2; else if (colt < C_VR) kind = 3; else if (colt < C_GR) kind = 0; else if (colt < C_GA) kind = 4; else kind = 5;
        EPI_LOOP_BEGIN
            if (kind == 1) { if (wc == 0) { const f32x4 c = *(const f32x4*)(cosA + (size_t)row * 16 + 4 * fq), s = *(const f32x4*)(sinA + (size_t)row * 16 + 4 * fq); rot8(v0, v1, c, s); } }
            else if (kind == 2 || kind == 3) { const int i0 = wc * 16 + 4 * fq; const f32x4 c = *(const f32x4*)(cosR + (size_t)row * 64 + i0), s = *(const f32x4*)(sinR + (size_t)row * 64 + i0); rot8(v0, v1, c, s);
                if (kind == 3) { v0 = v0 * QK_SCALE; v1 = v1 * QK_SCALE; } }
            else if (kind == 4) {
#pragma unroll
                for (int j = 0; j < 4; ++j) { v0[j] = v0[j] * sigmoidf_(v0[j]); v1[j] = v1[j] * sigmoidf_(v1[j]); } }
            else if (kind == 5) {
#pragma unroll
                for (int j = 0; j < 4; ++j) { v0[j] = sigmoidf_(v0[j]); v1[j] = sigmoidf_(v1[j]); } }
            *(v4u*)(O + (size_t)row * NIN + col) = pack8(v0, v1);
        EPI_LOOP_END
    }
};
struct EpiTmp {
    float* tmp; const bf16* proj;
    __device__ __forceinline__ void operator()(const f32x4 (&acc)[2][2][4][2], const pg8::Unit& u, int wr, int wc, int fr, int fq) const {
        EPI_LOOP_BEGIN
            f32x4 g0, g1; unpack8(*(const v4u*)(proj + (size_t)row * NIN + C_GA + col), g0, g1);
            *(f32x4*)(tmp + (size_t)row * D + col) = v0 * g0; *(f32x4*)(tmp + (size_t)row * D + col + 4) = v1 * g1;
        EPI_LOOP_END
    }
};
struct EpiMerged {
    const float* tmp; const bf16* proj; bf16* merged;
    __device__ __forceinline__ void operator()(const f32x4 (&acc)[2][2][4][2], const pg8::Unit& u, int wr, int wc, int fr, int fq) const {
        EPI_LOOP_BEGIN
            f32x4 g0, g1; unpack8(*(const v4u*)(proj + (size_t)row * NIN + C_GB + col), g0, g1);
            const f32x4 t0 = *(const f32x4*)(tmp + (size_t)row * D + col), t1 = *(const f32x4*)(tmp + (size_t)row * D + col + 4);
            v0 = t0 + v0 * g0; v1 = t1 + v1 * g1;
            *(v4u*)(merged + (size_t)row * D + col) = pack8(v0, v1);
        EPI_LOOP_END
    }
};
struct EpiR1 {
    const float* x; float* r1;
    __device__ __forceinline__ void operator()(const f32x4 (&acc)[2][2][4][2], const pg8::Unit& u, int wr, int wc, int fr, int fq) const {
        EPI_LOOP_BEGIN
            const f32x4 x0 = *(const f32x4*)(x + (size_t)row * D + col), x1 = *(const f32x4*)(x + (size_t)row * D + col + 4);
            *(f32x4*)(r1 + (size_t)row * D + col) = x0 * ALPHA + v0; *(f32x4*)(r1 + (size_t)row * D + col + 4) = x1 * ALPHA + v1;
        EPI_LOOP_END
    }
};
__device__ __forceinline__ float dot128(const bf16* a, const bf16* b) {
    float s = 0.f;
#pragma unroll
    for (int x = 0; x < 16; ++x) { const v4u qa = *(const GAS v4u*)(a + 8 * x), kb = *(const GAS v4u*)(b + 8 * x);
        s += bflo(qa.x) * bflo(kb.x) + bfhi(qa.x) * bfhi(kb.x) + bflo(qa.y) * bflo(kb.y) + bfhi(qa.y) * bfhi(kb.y) + bflo(qa.z) * bflo(kb.z) + bfhi(qa.z) * bfhi(kb.z) + bflo(qa.w) * bflo(kb.w) + bfhi(qa.w) * bfhi(kb.w); }
    return s;
}
__device__ __forceinline__ void p2_attn_ref(Frame& F, const Args& A) {
    const bf16* proj = WSP(bf16, WS_PROJ); bf16* oag = WSP(bf16, WS_OAG); float* lse = WSP(float, WS_LSE);
    const int gw = F.vcu * NWAVES + F.wave, NGW = F.G * NWAVES, lane = F.lane;
    for (int it = gw; it < 3 * 8 * T; it += NGW) {
        const int g = it / (8 * T), rem = it % (8 * T), t = rem >> 3, h = rem & 7;
        const int d = (g == 0) ? 1 : (g == 1 ? 4 : 16);
        const int m = t / d, nk = (m < 128 ? m : 128) + 1;
        const size_t hc = (size_t)(g * 8 + h) * 128;
        const bf16* q = proj + (size_t)t * NIN + C_QA + hc;
        float sc[3];
#pragma unroll
        for (int j = 0; j < 3; ++j) { const int s = lane + 64 * j; float a = -__builtin_inff();
            if (s < nk) a = dot128(q, proj + (size_t)(t - s * d) * NIN + C_KA + hc) * QK_SCALE;
            sc[j] = a; }
        const float mx = wave_max(fmaxf(sc[0], fmaxf(sc[1], sc[2])));
        float p[3];
#pragma unroll
        for (int j = 0; j < 3; ++j) p[j] = (lane + 64 * j < nk) ? __expf(sc[j] - mx) : 0.f;
        const float sum = wave_sum(p[0] + p[1] + p[2]);
        float o0 = 0.f, o1 = 0.f;
        for (int s = 0; s < nk; ++s) { const float pj = (s < 64) ? p[0] : (s < 128 ? p[1] : p[2]); const float pv = __shfl(pj, s & 63);
            const unsigned vv = *(const GAS unsigned*)(proj + (size_t)(t - s * d) * NIN + C_VA + hc + 2 * lane); o0 += pv * bflo(vv); o1 += pv * bfhi(vv); }
        const float rs = 1.f / sum;
        *(GAS unsigned*)(oag + ((size_t)g * T + t) * 1024 + h * 128 + 2 * lane) = pk2(o0 * rs, o1 * rs);
        if (lane == 0) lse[((size_t)g * T + t) * 8 + h] = mx + __logf(sum);
    }
}
__device__ __forceinline__ void p2_kv_ref(Frame& F, const Args& A) {
    const bf16* proj = WSP(bf16, WS_PROJ); bf16* kvT = WSP(bf16, WS_KV);
    const int gt = F.vcu * 512 + F.tid, NGT = F.G * 512;
    for (int idx = gt; idx < 64 * 8 * 256 * 128; idx += NGT) {
        const int d = idx & 127, e = (idx >> 7) & 255, h = (idx >> 15) & 7, c = idx >> 18;
        const float ld = logdecay(h); float acc = 0.f;
        for (int m = 0; m < 128; ++m) { const size_t r = (size_t)(c * 128 + m) * NIN;
            acc += bf2f(proj[r + C_KR + h * 128 + d]) * __expf((float)(127 - m) * ld) * bf2f(proj[r + C_VR + h * 256 + e]); }
        kvT[idx] = (bf16)f2bf(acc);
    }
}
__device__ __forceinline__ void p3_scan_combine(Frame& F, const Args& A) {
    const int gt = F.vcu * 512 + F.tid, NGT = F.G * 512;
    { const GAS unsigned* kv = (const GAS unsigned*)WSP(bf16, WS_KV); GAS unsigned* st = (GAS unsigned*)WSP(bf16, WS_ST);
      for (int i = gt; i < 131072; i += NGT) {
        const int h = i >> 14; const float dc = __expf(128.f * logdecay(h)); float s0 = 0.f, s1 = 0.f;
#pragma unroll 8
        for (int c = 0; c < 64; ++c) { const unsigned w = kv[(size_t)c * 131072 + i]; st[(size_t)c * 131072 + i] = pk2(s0, s1); s0 = dc * s0 + bflo(w); s1 = dc * s1 + bfhi(w); } } }
    { const bf16* oag = WSP(bf16, WS_OAG); const float* lse = WSP(float, WS_LSE); bf16* oa = WSP(bf16, WS_OA);
      for (int i = gt; i < T * 128; i += NGT) {
        const int t = i >> 7, ch = i & 127, h = ch >> 4;
        const float l0 = lse[(size_t)t * 8 + h], l1 = lse[((size_t)T + t) * 8 + h], l2 = lse[((size_t)2 * T + t) * 8 + h];
        const float mx = fmaxf(l0, fmaxf(l1, l2)); const float e0 = __expf(l0 - mx), e1 = __expf(l1 - mx), e2 = __expf(l2 - mx); const float rs = 1.f / (e0 + e1 + e2);
        f32x4 a0, a1, b0, b1, c0, c1;
        unpack8(*(const GAS v4u*)(oag + (size_t)t * 1024 + ch * 8), a0, a1); unpack8(*(const GAS v4u*)(oag + ((size_t)T + t) * 1024 + ch * 8), b0, b1); unpack8(*(const GAS v4u*)(oag + ((size_t)2 * T + t) * 1024 + ch * 8), c0, c1);
        const f32x4 r0 = (a0 * e0 + b0 * e1 + c0 * e2) * rs, r1 = (a1 * e0 + b1 * e1 + c1 * e2) * rs;
        v4u o; o.x = pk2(r0[0], r0[1]); o.y = pk2(r0[2], r0[3]); o.z = pk2(r1[0], r1[1]); o.w = pk2(r1[2], r1[3]);
        *(GAS v4u*)(oa + (size_t)t * 1024 + ch * 8) = o; } }
}
__device__ __forceinline__ void p4_ret_ref(Frame& F, const Args& A) {
    const bf16* proj = WSP(bf16, WS_PROJ); const bf16* stT = WSP(bf16, WS_ST); bf16* orr = WSP(bf16, WS_OR);
    const int gw = F.vcu * NWAVES + F.wave, NGW = F.G * NWAVES, lane = F.lane;
    for (int it = gw; it < T * 8; it += NGW) {
        const int t = it >> 3, h = it & 7, n = t & 127, c = t >> 7; const float ld = logdecay(h);
        const bf16* q = proj + (size_t)t * NIN + C_QR + h * 128;
        float sc[2];
#pragma unroll
        for (int j = 0; j < 2; ++j) { const int m = lane + 64 * j; float a = 0.f;
            if (m <= n) a = dot128(q, proj + (size_t)(c * 128 + m) * NIN + C_KR + h * 128) * __expf((float)(n - m) * ld);
            sc[j] = a; }
        float o[4] = {0.f, 0.f, 0.f, 0.f};
        for (int m = 0; m <= n; ++m) { const float pv = __shfl((m < 64) ? sc[0] : sc[1], m & 63); const bf16* v = proj + (size_t)(c * 128 + m) * NIN + C_VR + h * 256;
#pragma unroll
            for (int j = 0; j < 4; ++j) o[j] += pv * bf2f(v[lane + 64 * j]); }
        const float qd = __expf((float)(n + 1) * ld);
#pragma unroll
        for (int j = 0; j < 4; ++j) { const int e = lane + 64 * j; o[j] += qd * dot128(q, stT + ((size_t)(c * 8 + h) * 256 + e) * 128); }
        const float mean = wave_sum(o[0] + o[1] + o[2] + o[3]) * (1.f / 256.f);
        float q2 = 0.f;
#pragma unroll
        for (int j = 0; j < 4; ++j) { o[j] -= mean; q2 += o[j] * o[j]; }
        const float rstd = 1.f / sqrtf(wave_sum(q2) * (1.f / 256.f) + LN_EPS);
#pragma unroll
        for (int j = 0; j < 4; ++j) { const int e = lane + 64 * j; orr[(size_t)t * D + h * 256 + e] = (bf16)f2bf(bf2f(proj[(size_t)t * NIN + C_GR + h * 256 + e]) * o[j] * rstd); }
    }
}
__device__ __forceinline__ void p7_ln_router(Frame& F, const Args& A) {
    const int gw = F.vcu * NWAVES + F.wave, NGW = F.G * NWAVES, lane = F.lane;
    float* x1 = F.out; bf16* x1b = WSP(bf16, WS_X1B); float* asgw = WSP(float, WS_ASGW); int* asge = WSP(int, WS_ASGE); int* list = WSP(int, WS_LIST);
    LAS float* xs = (LAS float*)(F.lds + RING_OFF + F.wave * 16384);
    for (int t = gw; t < T; t += NGW) {
        { const GAS f32x4* sc4 = (const GAS f32x4*)A.in[I_LN1S]; const GAS f32x4* bi4 = (const GAS f32x4*)A.in[I_LN1B];
          GAS f32x4* xr = (GAS f32x4*)(x1 + (size_t)t * D) + lane;
          f32x4 v[8]; float s = 0.f;
#pragma unroll
          for (int j = 0; j < 8; ++j) { v[j] = xr[64 * j]; s += (v[j].x + v[j].y) + (v[j].z + v[j].w); }
          const float mean = wave_sum(s) * (1.f / D); float s2 = 0.f;
#pragma unroll
          for (int j = 0; j < 8; ++j) { v[j] = v[j] - mean; s2 += (v[j].x * v[j].x + v[j].y * v[j].y) + (v[j].z * v[j].z + v[j].w * v[j].w); }
          const float rstd = 1.f / sqrtf(wave_sum(s2) * (1.f / D) + LN_EPS);
          GAS v2u* o8 = (GAS v2u*)(x1b + (size_t)t * D) + lane;
#pragma unroll
          for (int j = 0; j < 8; ++j) { v[j] = v[j] * rstd * sc4[lane + 64 * j] + bi4[lane + 64 * j]; xr[64 * j] = v[j];
              v2u w; w.x = pk2(v[j].x, v[j].y); w.y = pk2(v[j].z, v[j].w); o8[64 * j] = w; *(LAS f32x4*)(xs + 4 * (lane + 64 * j)) = v[j]; } }
        LDS_WAIT(); asm volatile("" ::: "memory");
        float gl[4] = {0.f, 0.f, 0.f, 0.f};
        { const GAS f32x4* wg4 = (const GAS f32x4*)A.in[I_WGR];
#pragma unroll 4
          for (int i = 0; i < 32; ++i) { const int dd = lane + 64 * i; const f32x4 wv = wg4[dd]; const float xv = xs[dd]; gl[0] += xv * wv.x; gl[1] += xv * wv.y; gl[2] += xv * wv.z; gl[3] += xv * wv.w; } }
        const float* bg = A.in[I_BGR];
#pragma unroll
        for (int q = 0; q < 4; ++q) gl[q] = wave_sum(gl[q]) + bg[q];
        int gs = 0; float gm = gl[0];
#pragma unroll
        for (int q = 1; q < 4; ++q) if (gl[q] > gm) { gm = gl[q]; gs = q; }
        const float pg = 1.f / (__expf(gl[0] - gm) + __expf(gl[1] - gm) + __expf(gl[2] - gm) + __expf(gl[3] - gm));
        float el[8] = {0.f, 0.f, 0.f, 0.f, 0.f, 0.f, 0.f, 0.f};
        { const GAS f32x4* we4 = (const GAS f32x4*)(A.in[I_WER] + (size_t)gs * D * 8);
#pragma unroll 4
          for (int i = 0; i < 32; ++i) { const int dd = lane + 64 * i; const f32x4 w0 = we4[dd * 2], w1 = we4[dd * 2 + 1]; const float xv = xs[dd];
              el[0] += xv * w0.x; el[1] += xv * w0.y; el[2] += xv * w0.z; el[3] += xv * w0.w; el[4] += xv * w1.x; el[5] += xv * w1.y; el[6] += xv * w1.z; el[7] += xv * w1.w; } }
        const float* be = A.in[I_BER];
#pragma unroll
        for (int q = 0; q < 8; ++q) el[q] = wave_sum(el[q]) + be[gs * 8 + q];
        int i1 = 0; float v1 = el[0];
#pragma unroll
        for (int q = 1; q < 8; ++q) if (el[q] > v1) { v1 = el[q]; i1 = q; }
        int i2 = -1; float v2 = -__builtin_inff();
#pragma unroll
        for (int q = 0; q < 8; ++q) if (q != i1 && el[q] > v2) { v2 = el[q]; i2 = q; }
        const float e2 = __expf(v2 - v1); const float w1 = pg / (1.f + e2), w2 = pg * e2 / (1.f + e2);
        if (lane < 2) { const int ex = gs * 8 + (lane == 0 ? i1 : i2); const int a = t * 2 + lane;
            const unsigned pos = __hip_atomic_fetch_add((unsigned*)(F.ctl + CW_CNT + 64 * ex), 1u, RLX_AGENT);
            list[ex * LCAP + pos] = a; asgw[a] = (lane == 0) ? w1 : w2; asge[a] = ex; }
        LDS_WAIT(); asm volatile("" ::: "memory");
    }
}
__device__ __forceinline__ void p7_expert_weights(Frame& F, const Args& A) {
    LAS float* scr = (LAS float*)(F.lds + RING_OFF + F.wave * 16384);
    const int gw = F.vcu * NWAVES + F.wave, NGW = F.G * NWAVES;
    for (int it = gw; it < NEXP * 1536; it += NGW) {
        const int e = it / 1536; int r = it % 1536;
        if (r < 1024) { const int up = r >> 9; r &= 511; const int kb = r >> 4, nb = r & 15, n0 = 32 * nb;
            tr_item(A.in[up ? I_WEU : I_WEG] + (size_t)e * D * EHID, EHID, n0 + (F.lane & 31), 64 * kb, WSP(bf16, WS_WGU) + (size_t)e * 1024 * D, D, 256 * (n0 >> 7) + 128 * up + (n0 & 127), scr, F.lane); }
        else { r -= 1024; const int kb = r >> 6, nb = r & 63;
            tr_item(A.in[I_WED] + (size_t)e * EHID * D, D, 32 * nb + (F.lane & 31), 64 * kb, WSP(bf16, WS_WD) + (size_t)e * D * EHID, EHID, 32 * nb, scr, F.lane); }
    }
}
__device__ __forceinline__ float dotn(const bf16* a, const bf16* b, int n8) {
    float s = 0.f;
    for (int x = 0; x < n8; ++x) { const v4u qa = *(const GAS v4u*)(a + 8 * x), kb = *(const GAS v4u*)(b + 8 * x);
        s += bflo(qa.x) * bflo(kb.x) + bfhi(qa.x) * bfhi(kb.x) + bflo(qa.y) * bflo(kb.y) + bfhi(qa.y) * bfhi(kb.y) + bflo(qa.z) * bflo(kb.z) + bfhi(qa.z) * bfhi(kb.z) + bflo(qa.w) * bflo(kb.w) + bfhi(qa.w) * bfhi(kb.w); }
    return s;
}
__device__ __forceinline__ void p8_moe_ref(Frame& F, const Args& A) {
    const bf16* x1b = WSP(bf16, WS_X1B); const bf16* wgu = WSP(bf16, WS_WGU); const bf16* wd = WSP(bf16, WS_WD); const float* asgw = WSP(float, WS_ASGW); const int* asge = WSP(int, WS_ASGE);
    bf16* hidg = WSP(bf16, WS_HID); bf16* yb = WSP(bf16, WS_YBUF);
    const int gw = F.vcu * NWAVES + F.wave, NGW = F.G * NWAVES, lane = F.lane;
    for (int a = gw; a < 2 * T; a += NGW) {
        const int t = a >> 1, e = asge[a]; const float w = asgw[a];
        const bf16* xr = x1b + (size_t)t * D; const bf16* wg = wgu + (size_t)e * 1024 * D; bf16* hrow = hidg + (size_t)a * EHID;
#pragma unroll 1
        for (int i = 0; i < 8; ++i) { const int j = lane + 64 * i; const bf16* gr = wg + (size_t)(256 * (j >> 7) + (j & 127)) * D;
            const float gv = dotn(xr, gr, 256), uv = dotn(xr, gr + (size_t)128 * D, 256); hrow[j] = (bf16)f2bf(gv * sigmoidf_(gv) * uv); }
        VM_WAIT(); __builtin_amdgcn_fence(__ATOMIC_RELEASE, "workgroup"); __builtin_amdgcn_fence(__ATOMIC_ACQUIRE, "agent");
        const bf16* wdr = wd + (size_t)e * D * EHID;
#pragma unroll 1
        for (int i = 0; i < 32; ++i) { const int col = lane + 64 * i; yb[(size_t)a * D + col] = (bf16)f2bf(w * dotn(hrow, wdr + (size_t)col * EHID, 64)); }
    }
}
__device__ __forceinline__ void p10_final(Frame& F, const Args& A) {
    const int gw = F.vcu * NWAVES + F.wave, NGW = F.G * NWAVES, lane = F.lane;
    const bf16* yb = WSP(bf16, WS_YBUF);
    const GAS f32x4* sc4 = (const GAS f32x4*)A.in[I_LN2S]; const GAS f32x4* bi4 = (const GAS f32x4*)A.in[I_LN2B];
    for (int t = gw; t < T; t += NGW) {
        GAS f32x4* xr = (GAS f32x4*)(F.out + (size_t)t * D) + lane;
        const GAS v2u* y0 = (const GAS v2u*)(yb + (size_t)(2 * t) * D) + lane; const GAS v2u* y1 = (const GAS v2u*)(yb + (size_t)(2 * t + 1) * D) + lane;
        f32x4 v[8]; float s = 0.f;
#pragma unroll
        for (int j = 0; j < 8; ++j) { const f32x4 xv = xr[64 * j]; const v2u a = y0[64 * j], b = y1[64 * j];
            v[j] = xv * ALPHA + (f32x4){bflo(a.x) + bflo(b.x), bfhi(a.x) + bfhi(b.x), bflo(a.y) + bflo(b.y), bfhi(a.y) + bfhi(b.y)};
            s += (v[j].x + v[j].y) + (v[j].z + v[j].w); }
        const float mean = wave_sum(s) * (1.f / D); float s2 = 0.f;
#pragma unroll
        for (int j = 0; j < 8; ++j) { v[j] = v[j] - mean; s2 += (v[j].x * v[j].x + v[j].y * v[j].y) + (v[j].z * v[j].z + v[j].w * v[j].w); }
        const float rstd = 1.f / sqrtf(wave_sum(s2) * (1.f / D) + LN_EPS);
#pragma unroll
        for (int j = 0; j < 8; ++j) xr[64 * j] = v[j] * rstd * sc4[lane + 64 * j] + bi4[lane + 64 * j];
    }
}
struct MoeOrder {
    const LAS int* tab; const LAS int* cnt; const int* list; int nRT, nN, G, c;
    __device__ __forceinline__ bool next(int i, pg8::Unit& u) const {
        const int L = i * G + c; if (L >= nRT * nN) return false;
        const int rt = L / nN; u.pm = rt; u.pn = L - rt * nN; const int tv = tab[rt]; u.e = tv & 255; u.lt = tv >> 8; return true;
    }
    __device__ __forceinline__ void a_rows(const pg8::Unit& u, unsigned (&v)[2][2], const int (&RA)[2], const int (&CA)[2], int K) const {
        const int n = cnt[u.e];
#pragma unroll
        for (int h = 0; h < 2; ++h)
#pragma unroll
            for (int i = 0; i < 2; ++i) { const int idx = u.lt * 256 + h * 128 + RA[i]; const int tok = (idx < n) ? (list[u.e * LCAP + idx] >> 1) : 0; v[h][i] = (unsigned)(tok * K + CA[i]) * 2u; }
    }
};
__device__ __forceinline__ int moe_tables(Frame& F) {
    LAS int* tab = (LAS int*)(F.lds + MOE_TAB_OFF); LAS int* cnt = (LAS int*)(F.lds + MOE_CNT_OFF);
    if (F.tid < NEXP) cnt[F.tid] = (int)__hip_atomic_load((unsigned*)(F.ctl + CW_CNT + 64 * F.tid), RLX_AGENT);
    __syncthreads();
    if (F.tid == 0) { int rt = 0; for (int e = 0; e < NEXP; ++e) { const int nt = (cnt[e] + 255) >> 8; for (int lt = 0; lt < nt; ++lt) tab[rt++] = e | (lt << 8); } tab[127] = rt; }
    __syncthreads();
    return tab[127];
}
struct EpiHid {
    bf16* hid;
    __device__ __forceinline__ void operator()(const f32x4 (&acc)[2][2][4][2], const pg8::Unit& u, int wr, int wc, int fr, int fq) const {
        const int row0 = u.pm * 256 + wr * 64 + fr, col = u.pn * 128 + wc * 32 + 8 * fq;
#pragma unroll
        for (int ai = 0; ai < 2; ++ai)
#pragma unroll
            for (int m = 0; m < 4; ++m) { const int row = row0 + ai * 128 + m * 16; f32x4 h0, h1;
#pragma unroll
                for (int j = 0; j < 4; ++j) { const float g0 = acc[ai][0][m][0][j], g1 = acc[ai][0][m][1][j]; h0[j] = g0 * sigmoidf_(g0) * acc[ai][1][m][0][j]; h1[j] = g1 * sigmoidf_(g1) * acc[ai][1][m][1][j]; }
                *(v4u*)(hid + (size_t)row * EHID + col) = pack8(h0, h1); }
    }
};
struct EpiY {
    bf16* yb; const int* list; const float* asgw; const LAS int* cnt;
    __device__ __forceinline__ void operator()(const f32x4 (&acc)[2][2][4][2], const pg8::Unit& u, int wr, int wc, int fr, int fq) const {
        const int n = cnt[u.e], colw = u.pn * 256 + wc * 32 + 8 * fq;
#pragma unroll
        for (int ai = 0; ai < 2; ++ai)
#pragma unroll
            for (int m = 0; m < 4; ++m) { const int idx = u.lt * 256 + ai * 128 + wr * 64 + m * 16 + fr;
                if (idx < n) { const int a = list[u.e * LCAP + idx]; const float w = asgw[a];
#pragma unroll
                    for (int bj = 0; bj < 2; ++bj) *(v4u*)(yb + (size_t)a * D + colw + bj * 128) = pack8(acc[ai][bj][m][0] * w, acc[ai][bj][m][1] * w); } }
    }
};
typedef short hx8 __attribute__((ext_vector_type(8)));
typedef short s16x4 __attribute__((ext_vector_type(4)));
typedef float f32x16 __attribute__((ext_vector_type(16)));
typedef float f32x8 __attribute__((ext_vector_type(8)));
typedef __bf16 bfv8 __attribute__((ext_vector_type(8)));
typedef __bf16 bfv4 __attribute__((ext_vector_type(4)));
#define MFMA32(a, b, c) __builtin_amdgcn_mfma_f32_32x32x16_bf16((a), (b), (c), 0, 0, 0)
constexpr float LOG2E = 1.4426950408889634f, LN2 = 0.6931471805599453f;
__device__ __forceinline__ unsigned off_b(unsigned row, unsigned ch) { return 256u * row + 16u * (ch ^ (((row & 3) << 2) | ((row >> 2) & 3))); }
__device__ __forceinline__ int crow(int reg, int hh) { return (reg & 3) + 8 * (reg >> 2) + 4 * hh; }
__device__ __forceinline__ unsigned tr_addr(int lane, int rowbase, int ct) { const int blk = (lane >> 4) & 1, q = (lane & 15) >> 2, p = lane & 3; return off_b(rowbase + q, 4 * ct + 2 * blk + (p >> 1)) + 8 * (p & 1); }
__device__ __forceinline__ hx8 tr_pair(unsigned a0, unsigned a1) { s16x4 lo, hi;
    asm volatile("ds_read_b64_tr_b16 %0, %2\n\tds_read_b64_tr_b16 %1, %3\n\ts_waitcnt lgkmcnt(0)" : "=&v"(lo), "=&v"(hi) : "v"(a0), "v"(a1) : "memory");
    return __builtin_shufflevector(lo, hi, 0, 1, 2, 3, 4, 5, 6, 7); }
__device__ __forceinline__ void tr_quad(const unsigned (&a)[8], hx8 (&o)[4]) { s16x4 r0, r1, r2, r3, r4, r5, r6, r7;
    asm volatile("ds_read_b64_tr_b16 %0, %8\n\tds_read_b64_tr_b16 %1, %9\n\tds_read_b64_tr_b16 %2, %10\n\tds_read_b64_tr_b16 %3, %11\n\tds_read_b64_tr_b16 %4, %12\n\tds_read_b64_tr_b16 %5, %13\n\tds_read_b64_tr_b16 %6, %14\n\tds_read_b64_tr_b16 %7, %15\n\ts_waitcnt lgkmcnt(0)"
        : "=&v"(r0), "=&v"(r1), "=&v"(r2), "=&v"(r3), "=&v"(r4), "=&v"(r5), "=&v"(r6), "=&v"(r7) : "v"(a[0]), "v"(a[1]), "v"(a[2]), "v"(a[3]), "v"(a[4]), "v"(a[5]), "v"(a[6]), "v"(a[7]) : "memory");
    o[0] = __builtin_shufflevector(r0, r1, 0, 1, 2, 3, 4, 5, 6, 7); o[1] = __builtin_shufflevector(r2, r3, 0, 1, 2, 3, 4, 5, 6, 7);
    o[2] = __builtin_shufflevector(r4, r5, 0, 1, 2, 3, 4, 5, 6, 7); o[3] = __builtin_shufflevector(r6, r7, 0, 1, 2, 3, 4, 5, 6, 7); }
template <int OFF> __device__ __forceinline__ void tr_quad_off(const unsigned (&a)[8], hx8 (&o)[4]) { s16x4 r0, r1, r2, r3, r4, r5, r6, r7;
    asm volatile("ds_read_b64_tr_b16 %0, %8 offset:%16\n\tds_read_b64_tr_b16 %1, %9 offset:%16\n\tds_read_b64_tr_b16 %2, %10 offset:%16\n\tds_read_b64_tr_b16 %3, %11 offset:%16\n\tds_read_b64_tr_b16 %4, %12 offset:%16\n\tds_read_b64_tr_b16 %5, %13 offset:%16\n\tds_read_b64_tr_b16 %6, %14 offset:%16\n\tds_read_b64_tr_b16 %7, %15 offset:%16\n\ts_waitcnt lgkmcnt(0)"
        : "=&v"(r0), "=&v"(r1), "=&v"(r2), "=&v"(r3), "=&v"(r4), "=&v"(r5), "=&v"(r6), "=&v"(r7) : "v"(a[0]), "v"(a[1]), "v"(a[2]), "v"(a[3]), "v"(a[4]), "v"(a[5]), "v"(a[6]), "v"(a[7]), "i"(OFF) : "memory");
    o[0] = __builtin_shufflevector(r0, r1, 0, 1, 2, 3, 4, 5, 6, 7); o[1] = __builtin_shufflevector(r2, r3, 0, 1, 2, 3, 4, 5, 6, 7);
    o[2] = __builtin_shufflevector(r4, r5, 0, 1, 2, 3, 4, 5, 6, 7); o[3] = __builtin_shufflevector(r6, r7, 0, 1, 2, 3, 4, 5, 6, 7); }
template <int S> __device__ __forceinline__ hx8 pack_step(const f32x16& x) { f32x8 v;
#pragma unroll
    for (int j = 0; j < 8; ++j) v[j] = x[8 * S + j];
    return __builtin_bit_cast(hx8, __builtin_convertvector(v, bfv8)); }
__device__ __forceinline__ v2u pack4(float a, float b, float c, float d) { typedef float f4 __attribute__((ext_vector_type(4))); const f4 v = {a, b, c, d}; return __builtin_bit_cast(v2u, __builtin_convertvector(v, bfv4)); }
__device__ __forceinline__ f32x16 zero16() { f32x16 z;
#pragma unroll
    for (int i = 0; i < 16; ++i) z[i] = 0.f;
    return z; }

struct AttnUnit { int g, head, d, r, nq; size_t hc; };
__device__ __forceinline__ AttnUnit attn_unit(int u) { AttnUnit a; a.g = u >> 9; a.head = (u >> 6) & 7; const int nqr = u & 63; a.d = (a.g == 0) ? 1 : (a.g == 1 ? 4 : 16); const int nb = 64 / a.d; a.r = nqr / nb; a.nq = nqr % nb; a.hc = (size_t)(a.g * 8 + a.head) * 128; return a; }
#define LBAR() do { asm volatile("s_waitcnt lgkmcnt(0)" ::: "memory"); __builtin_amdgcn_s_barrier(); asm volatile("" ::: "memory"); } while (0)
__device__ __forceinline__ void p2_attn_mfma(Frame& F) {
    const bf16* proj = WSP(bf16, WS_PROJ); bf16* oag = WSP(bf16, WS_OAG); float* lse = WSP(float, WS_LSE);
    const int tid = F.tid, lane = F.lane, w = F.wave, c = lane & 31, hh = lane >> 5;
    LAS unsigned char* KI = F.lds + RING_OFF; LAS unsigned char* VI = F.lds + RING_OFF + 65536;
    const unsigned vbase = (unsigned)(uintptr_t)VI;
    const int u0 = F.vcu, NU = 3 * 8 * 64;
    __syncthreads();
    if (w >= 4) {
        const int lt = tid - 256;
        v4u kr[16], vr[16];
#define ATT_ISSUE(U) do { const AttnUnit a_ = attn_unit(U); _Pragma("unroll") for (int i = 0; i < 16; ++i) { const int ci = lt + 256 * i, row = ci >> 4, ch = ci & 15; const int m = 128 * (a_.nq - 1) + row; \
            if (m >= 0) { const size_t p = ((size_t)m * a_.d + a_.r) * NIN + a_.hc + ch * 8; kr[i] = *(const GAS v4u*)(proj + p + C_KA); vr[i] = *(const GAS v4u*)(proj + p + C_VA); } \
            else { kr[i] = (v4u){0u, 0u, 0u, 0u}; vr[i] = (v4u){0u, 0u, 0u, 0u}; } } } while (0)
#define ATT_WRITE(IMG, REGS) do { _Pragma("unroll") for (int i = 0; i < 16; ++i) { const int ci = lt + 256 * i, row = ci >> 4, ch = ci & 15; *(LAS v4u*)((IMG) + off_b(row, ch)) = REGS[i]; } } while (0)
        if (u0 < NU) { ATT_ISSUE(u0); ATT_WRITE(KI, kr); }
        LBAR();
        for (int u = u0; u < NU; u += F.G) {
            const int un = u + F.G; const bool has_next = un < NU;
            ATT_WRITE(VI, vr);
            if (has_next) ATT_ISSUE(un);
            LBAR();
            if (has_next) ATT_WRITE(KI, kr);
            LBAR();
        }
#undef ATT_ISSUE
#undef ATT_WRITE
    } else {
        hx8 qf[8];
#define ATT_LOADQ(U) do { const AttnUnit a_ = attn_unit(U); const size_t qp_ = (size_t)(128 * a_.nq + 32 * w + c) * a_.d + a_.r; \
            _Pragma("unroll") for (int s = 0; s < 8; ++s) qf[s] = *(const GAS hx8*)(proj + qp_ * NIN + C_QA + a_.hc + 16 * s + 8 * hh); } while (0)
        if (u0 < NU) ATT_LOADQ(u0);
        LBAR();
        for (int u = u0; u < NU; u += F.G) {
            const int un = u + F.G; const bool has_next = un < NU;
            const AttnUnit a = attn_unit(u); const int nq = a.nq;
            const size_t qpos = (size_t)(128 * nq + 32 * w + c) * a.d + a.r;
            f32x16 X[5]; float mx = -1e30f;
            constexpr float SC = QK_SCALE * LOG2E;
#pragma unroll
            for (int tt = 0; tt < 5; ++tt) {
                const int Tk = w + tt; const bool tv = (nq > 0) || (Tk >= 4);
                X[tt] = zero16();
                if (tv) {
#pragma unroll
                    for (int s = 0; s < 8; ++s) { const hx8 kf = *(const LAS hx8*)(KI + 8192 * Tk + off_b(c, 2 * s + hh)); X[tt] = MFMA32(kf, qf[s], X[tt]); } }
#pragma unroll
                for (int rg = 0; rg < 16; ++rg) { const int kr_ = crow(rg, hh); const bool ok = tv && (tt == 0 ? kr_ >= c : (tt == 4 ? kr_ <= c : true));
                    const float sv = ok ? X[tt][rg] * SC : -__builtin_inff(); X[tt][rg] = sv; mx = fmaxf(mx, sv); }
            }
            mx = fmaxf(mx, __shfl_xor(mx, 32));
            float l = 0.f;
#pragma unroll
            for (int tt = 0; tt < 5; ++tt)
#pragma unroll
                for (int rg = 0; rg < 16; ++rg) { const float pv = __builtin_amdgcn_exp2f(X[tt][rg] - mx); X[tt][rg] = pv; l += pv; }
            l += __shfl_xor(l, 32);
            LBAR();
            f32x16 O[4];
#pragma unroll
            for (int dt = 0; dt < 4; ++dt) O[dt] = zero16();
            unsigned vb[8];
#pragma unroll
            for (int dt = 0; dt < 4; ++dt) { vb[2 * dt] = vbase + 8192u * (unsigned)w + tr_addr(lane, 4 * hh, dt); vb[2 * dt + 1] = vbase + 8192u * (unsigned)w + tr_addr(lane, 8 + 4 * hh, dt); }
#define ATT_PV(tt) do { const bool tv = (nq > 0) || (w + (tt) >= 4); if (tv) { hx8 vf[4]; \
                { const hx8 pf = pack_step<0>(X[tt]); tr_quad_off<8192 * (tt)>(vb, vf); _Pragma("unroll") for (int dt = 0; dt < 4; ++dt) O[dt] = MFMA32(vf[dt], pf, O[dt]); } \
                { const hx8 pf = pack_step<1>(X[tt]); tr_quad_off<8192 * (tt) + 4096>(vb, vf); _Pragma("unroll") for (int dt = 0; dt < 4; ++dt) O[dt] = MFMA32(vf[dt], pf, O[dt]); } } } while (0)
            ATT_PV(0); ATT_PV(1); ATT_PV(2); ATT_PV(3); ATT_PV(4);
#undef ATT_PV
            if (has_next) ATT_LOADQ(un);
            const float il = 1.f / l;
            bf16* orow = oag + ((size_t)a.g * T + qpos) * 1024 + a.head * 128 + 4 * hh;
#pragma unroll
            for (int dt = 0; dt < 4; ++dt)
#pragma unroll
                for (int rg = 0; rg < 4; ++rg) *(GAS v2u*)(orow + 32 * dt + 8 * rg) = pack4(O[dt][4 * rg] * il, O[dt][4 * rg + 1] * il, O[dt][4 * rg + 2] * il, O[dt][4 * rg + 3] * il);
            if (hh == 0) lse[((size_t)a.g * T + qpos) * 8 + a.head] = (mx + __log2f(l)) * LN2;
            LBAR();
        }
#undef ATT_LOADQ
    }
}
__device__ __forceinline__ void p2_kv_mfma(Frame& F) {
    const bf16* proj = WSP(bf16, WS_PROJ); bf16* kvT = WSP(bf16, WS_KV);
    const int tid = F.tid, lane = F.lane, w = F.wave, c = lane & 31, hh = lane >> 5;
    LAS unsigned char* KI = F.lds + RING_OFF; LAS unsigned char* VI = F.lds + RING_OFF + 32768;
    const unsigned kbase = (unsigned)(uintptr_t)KI, vbase = (unsigned)(uintptr_t)VI + 32768u * (unsigned)(w >> 2);
    for (int u = F.vcu; u < 64 * 8; u += F.G) {
        const int cc = u >> 3, h = u & 7; const float ld = logdecay(h);
        __syncthreads();
        {   v4u kv[4], vv[8];
#pragma unroll
            for (int i = 0; i < 4; ++i) { const int ci = tid + 512 * i, row = ci >> 4, ch = ci & 15; kv[i] = *(const GAS v4u*)(proj + (size_t)(cc * 128 + row) * NIN + C_KR + h * 128 + ch * 8); }
#pragma unroll
            for (int i = 0; i < 8; ++i) { const int ci = tid + 512 * i, row = ci >> 5, ch = ci & 31; vv[i] = *(const GAS v4u*)(proj + (size_t)(cc * 128 + row) * NIN + C_VR + h * 256 + ch * 8); }
#pragma unroll
            for (int i = 0; i < 4; ++i) { const int ci = tid + 512 * i, row = ci >> 4, ch = ci & 15; const float kd = __expf((float)(127 - row) * ld);
                f32x4 a, b; unpack8(kv[i], a, b); a = a * kd; b = b * kd; v4u o; o.x = pk2(a[0], a[1]); o.y = pk2(a[2], a[3]); o.z = pk2(b[0], b[1]); o.w = pk2(b[2], b[3]);
                *(LAS v4u*)(KI + off_b(row, ch)) = o; }
#pragma unroll
            for (int i = 0; i < 8; ++i) { const int ci = tid + 512 * i, row = ci >> 5, ch = ci & 31; *(LAS v4u*)(VI + 32768 * (ch >> 4) + off_b(row, ch & 15)) = vv[i]; }
        }
        __syncthreads();
        f32x16 acc[4];
#pragma unroll
        for (int dt = 0; dt < 4; ++dt) acc[dt] = zero16();
#pragma unroll 2
        for (int ks = 0; ks < 8; ++ks) {
            const hx8 vf = tr_pair(vbase + tr_addr(lane, 16 * ks + 8 * hh, w & 3), vbase + tr_addr(lane, 16 * ks + 8 * hh + 4, w & 3));
            unsigned a[8]; hx8 kf[4];
#pragma unroll
            for (int dt = 0; dt < 4; ++dt) { a[2 * dt] = kbase + tr_addr(lane, 16 * ks + 8 * hh, dt); a[2 * dt + 1] = kbase + tr_addr(lane, 16 * ks + 8 * hh + 4, dt); }
            tr_quad(a, kf);
#pragma unroll
            for (int dt = 0; dt < 4; ++dt) acc[dt] = MFMA32(kf[dt], vf, acc[dt]);
        }
        bf16* orow = kvT + ((size_t)u * 256 + 32 * w + c) * 128 + 4 * hh;
#pragma unroll
        for (int dt = 0; dt < 4; ++dt)
#pragma unroll
            for (int rg = 0; rg < 4; ++rg) *(GAS v2u*)(orow + 32 * dt + 8 * rg) = pack4(acc[dt][4 * rg], acc[dt][4 * rg + 1], acc[dt][4 * rg + 2], acc[dt][4 * rg + 3]);
    }
}
__device__ __forceinline__ void p4_ret_mfma(Frame& F) {
    const bf16* proj = WSP(bf16, WS_PROJ); const bf16* stT = WSP(bf16, WS_ST); bf16* orr = WSP(bf16, WS_OR);
    const int tid = F.tid, lane = F.lane, w = F.wave, c = lane & 31, hh = lane >> 5, nt = w & 3, eh = w >> 2;
    LAS unsigned char* KI = F.lds + RING_OFF; LAS unsigned char* VI = F.lds + RING_OFF + 32768; LAS float* ST = (LAS float*)(F.lds + RING_OFF + 98304);
    const unsigned vbase = (unsigned)(uintptr_t)VI + 32768u * (unsigned)eh;
    for (int u = F.vcu; u < 64 * 8; u += F.G) {
        const int cc = u >> 3, h = u & 7; const float ld = logdecay(h);
        __syncthreads();
        {   v4u kv[4], vv[8];
#pragma unroll
            for (int i = 0; i < 4; ++i) { const int ci = tid + 512 * i, row = ci >> 4, ch = ci & 15; kv[i] = *(const GAS v4u*)(proj + (size_t)(cc * 128 + row) * NIN + C_KR + h * 128 + ch * 8); }
#pragma unroll
            for (int i = 0; i < 8; ++i) { const int ci = tid + 512 * i, row = ci >> 5, ch = ci & 31; vv[i] = *(const GAS v4u*)(proj + (size_t)(cc * 128 + row) * NIN + C_VR + h * 256 + ch * 8); }
#pragma unroll
            for (int i = 0; i < 4; ++i) { const int ci = tid + 512 * i, row = ci >> 4, ch = ci & 15; *(LAS v4u*)(KI + off_b(row, ch)) = kv[i]; }
#pragma unroll
            for (int i = 0; i < 8; ++i) { const int ci = tid + 512 * i, row = ci >> 5, ch = ci & 31; *(LAS v4u*)(VI + 32768 * (ch >> 4) + off_b(row, ch & 15)) = vv[i]; }
        }
        __syncthreads();
        const int n = 32 * nt + c; const size_t trow = (size_t)(cc * 128 + n);
        hx8 qf[8];
#pragma unroll
        for (int s = 0; s < 8; ++s) qf[s] = *(const GAS hx8*)(proj + trow * NIN + C_QR + h * 128 + 16 * s + 8 * hh);
        f32x16 O[4];
        const float qd = __expf((float)(n + 1) * ld);
#pragma unroll
        for (int et = 0; et < 4; ++et) { O[et] = zero16(); const bf16* srow = stT + ((size_t)u * 256 + 128 * eh + 32 * et + c) * 128 + 8 * hh;
#pragma unroll
            for (int s = 0; s < 8; ++s) { const hx8 sf = *(const GAS hx8*)(srow + 16 * s); O[et] = MFMA32(sf, qf[s], O[et]); }
#pragma unroll
            for (int rg = 0; rg < 16; ++rg) O[et][rg] *= qd; }
        for (int mt = 0; mt <= nt; ++mt) {
            f32x16 X = zero16();
#pragma unroll
            for (int s = 0; s < 8; ++s) { const hx8 kf = *(const LAS hx8*)(KI + 8192 * mt + off_b(c, 2 * s + hh)); X = MFMA32(kf, qf[s], X); }
#pragma unroll
            for (int rg = 0; rg < 16; ++rg) { const int dn = 32 * (nt - mt) + c - crow(rg, hh); X[rg] = (dn >= 0) ? X[rg] * __expf((float)dn * ld) : 0.f; }
            { const hx8 pf = pack_step<0>(X); unsigned a[8]; hx8 vf[4];
#pragma unroll
              for (int et = 0; et < 4; ++et) { a[2 * et] = vbase + tr_addr(lane, 32 * mt + 4 * hh, et); a[2 * et + 1] = vbase + tr_addr(lane, 32 * mt + 8 + 4 * hh, et); }
              tr_quad(a, vf);
#pragma unroll
              for (int et = 0; et < 4; ++et) O[et] = MFMA32(vf[et], pf, O[et]); }
            { const hx8 pf = pack_step<1>(X); unsigned a[8]; hx8 vf[4];
#pragma unroll
              for (int et = 0; et < 4; ++et) { a[2 * et] = vbase + tr_addr(lane, 32 * mt + 16 + 4 * hh, et); a[2 * et + 1] = vbase + tr_addr(lane, 32 * mt + 24 + 4 * hh, et); }
              tr_quad(a, vf);
#pragma unroll
              for (int et = 0; et < 4; ++et) O[et] = MFMA32(vf[et], pf, O[et]); }
        }
        float s1 = 0.f, s2 = 0.f;
#pragma unroll
        for (int et = 0; et < 4; ++et)
#pragma unroll
            for (int rg = 0; rg < 16; ++rg) { const float x = O[et][rg]; s1 += x; s2 += x * x; }
        s1 += __shfl_xor(s1, 32); s2 += __shfl_xor(s2, 32);
        if (hh == 0) { ST[(n * 2 + eh) * 2] = s1; ST[(n * 2 + eh) * 2 + 1] = s2; }
        __syncthreads();
        const float t1 = ST[(n * 2) * 2] + ST[(n * 2 + 1) * 2], t2 = ST[(n * 2) * 2 + 1] + ST[(n * 2 + 1) * 2 + 1];
        const float mean = t1 * (1.f / 256.f), var = fmaxf(t2 * (1.f / 256.f) - mean * mean, 0.f), rstd = 1.f / sqrtf(var + LN_EPS);
        const bf16* grow = proj + trow * NIN + C_GR + h * 256 + 128 * eh + 4 * hh; bf16* orow = orr + trow * D + h * 256 + 128 * eh + 4 * hh;
#pragma unroll
        for (int et = 0; et < 4; ++et)
#pragma unroll
            for (int rg = 0; rg < 4; ++rg) { const v2u gw = *(const GAS v2u*)(grow + 32 * et + 8 * rg);
                *(GAS v2u*)(orow + 32 * et + 8 * rg) = pack4((O[et][4 * rg] - mean) * rstd * bflo(gw.x), (O[et][4 * rg + 1] - mean) * rstd * bfhi(gw.x), (O[et][4 * rg + 2] - mean) * rstd * bflo(gw.y), (O[et][4 * rg + 3] - mean) * rstd * bfhi(gw.y)); }
    }
}

__device__ __forceinline__ void ph1_proj(Frame& F, const Args& A) {
    pg8::Gemm g{WSP(bf16, WS_XB), WSP(bf16, WS_WINT), D, 0}; pg8::StaticOrder S; S.init(T, NIN, F.G, (int)blockIdx.x);
    EpiProj E{WSP(bf16, WS_PROJ), WSP(float, WS_COSA), WSP(float, WS_SINA), WSP(float, WS_COSR), WSP(float, WS_SINR)};
    pg8::gemm_phase<EpiProj, pg8::StaticOrder, true, false>(F.lds + RING_OFF, g, S, E);
}
__device__ __forceinline__ void ph5_merge(Frame& F, const Args& A) {
    { pg8::Gemm g{WSP(bf16, WS_OA), WSP(bf16, WS_WAT), 1024, 0}; pg8::StaticOrder S; S.init(T, D, F.G, (int)blockIdx.x);
      EpiTmp E{WSP(float, WS_TMP), WSP(bf16, WS_PROJ)};
      pg8::gemm_phase<EpiTmp, pg8::StaticOrder, true, false>(F.lds + RING_OFF, g, S, E); }
    { pg8::Gemm g{WSP(bf16, WS_OR), WSP(bf16, WS_WRT), 2048, 0}; pg8::StaticOrder S; S.init(T, D, F.G, (int)blockIdx.x);
      EpiMerged E{WSP(float, WS_TMP), WSP(bf16, WS_PROJ), WSP(bf16, WS_MERGED)};
      pg8::gemm_phase<EpiMerged, pg8::StaticOrder, true, false>(F.lds + RING_OFF, g, S, E); }
}
__device__ __forceinline__ void ph6_out(Frame& F, const Args& A) {
    pg8::Gemm g{WSP(bf16, WS_MERGED), WSP(bf16, WS_WOT), 2048, 0}; pg8::StaticOrder S; S.init(T, D, F.G, (int)blockIdx.x);
    EpiR1 E{A.in[I_X], F.out};
    pg8::gemm_phase<EpiR1, pg8::StaticOrder, true, false>(F.lds + RING_OFF, g, S, E);
}
__device__ __forceinline__ void ph8_moe1(Frame& F, const Args& A) {
    const int nRT = moe_tables(F);
    pg8::Gemm g{WSP(bf16, WS_X1B), WSP(bf16, WS_WGU), 2048, (size_t)1024 * D * 2};
    MoeOrder S{(const LAS int*)(F.lds + MOE_TAB_OFF), (const LAS int*)(F.lds + MOE_CNT_OFF), WSP(int, WS_LIST), nRT, 4, F.G, (int)blockIdx.x};
    EpiHid E{WSP(bf16, WS_HID)};
    pg8::gemm_phase<EpiHid, MoeOrder, true, true>(F.lds + RING_OFF, g, S, E);
}
__device__ __forceinline__ void ph9_moe2(Frame& F, const Args& A) {
    const int nRT = moe_tables(F);
    pg8::Gemm g{WSP(bf16, WS_HID), WSP(bf16, WS_WD), EHID, (size_t)D * EHID * 2};
    MoeOrder S{(const LAS int*)(F.lds + MOE_TAB_OFF), (const LAS int*)(F.lds + MOE_CNT_OFF), WSP(int, WS_LIST), nRT, 8, F.G, (int)blockIdx.x};
    EpiY E{WSP(bf16, WS_YBUF), WSP(int, WS_LIST), WSP(float, WS_ASGW), (const LAS int*)(F.lds + MOE_CNT_OFF)};
    pg8::gemm_phase<EpiY, MoeOrder, true, false>(F.lds + RING_OFF, g, S, E);
}

constexpr int N_PHASES = 11;
__global__ void __launch_bounds__(NWAVES * 64, 2) fwd_kernel(Args args) {
    extern __shared__ __attribute__((aligned(16))) unsigned char lds[];
    Frame F;
    F.lds = (LAS unsigned char*)lds;
    F.MISC = (volatile LAS unsigned*)(F.lds + MISC_OFF);
    F.tid = threadIdx.x; F.lane = F.tid & 63; F.wave = __builtin_amdgcn_readfirstlane(F.tid >> 6);
    F.G = gridDim.x; { const int bx = blockIdx.x; F.vcu = (F.G % 8 == 0) ? (bx % 8) * (F.G / 8) + bx / 8 : bx; }
    F.ws = args.ws; F.ctl = (gu32*)(args.ws + WS_CTL); F.out = args.out;
    const Args& A = args;
    for (int u = F.tid; u < (LDS_BYTES - LDSCTL_OFF) / 4; u += NWAVES * 64) ((LAS unsigned*)(F.lds + LDSCTL_OFF))[u] = 0u;
    __syncthreads();
    XcdBarrier bar; bar.bar = (unsigned*)(F.ctl + CW_BAR); bar.x = 0; bar.st = nullptr;
    if (!MK_SPLIT) bar = xcd_barrier_post((unsigned*)(F.ctl + CW_BAR), F.MISC + 8);
    const int lo = args.ph_lo, hi = args.ph_hi;
#ifndef PH_MASK
#define PH_MASK 0xFFFF
#endif
#define IN(k) (((PH_MASK >> (k)) & 1) && lo <= (k) && (k) < hi)
#ifndef USE_REF
#define USE_REF 0
#endif
#ifndef DBL_MASK
#define DBL_MASK 0
#endif
#define DBLQ(k) ((DBL_MASK >> (k)) & 1)
#define SEAM(k) do { if (IN(k) && IN((k) + 1)) xcd_barrier(bar); } while (0)

    if (IN(0)) { p0_prologue(F, A); if (DBLQ(0)) { __syncthreads(); p0_prologue(F, A); } } SEAM(0);
    if (IN(1)) { ph1_proj(F, A); if (DBLQ(1)) ph1_proj(F, A); } SEAM(1);
    if (IN(2)) { if (USE_REF & 1) p2_attn_ref(F, A); else { p2_attn_mfma(F); if (DBLQ(12)) p2_attn_mfma(F); } if (USE_REF & 2) p2_kv_ref(F, A); else { p2_kv_mfma(F); if (DBLQ(13)) p2_kv_mfma(F); } } SEAM(2);
    if (IN(3)) { p3_scan_combine(F, A); if (DBLQ(3)) p3_scan_combine(F, A); } SEAM(3);
    if (IN(4)) { if (USE_REF & 4) p4_ret_ref(F, A); else { p4_ret_mfma(F); if (DBLQ(4)) p4_ret_mfma(F); } } SEAM(4);
    if (IN(5)) { ph5_merge(F, A); if (DBLQ(5)) ph5_merge(F, A); } SEAM(5);
    if (IN(6)) { ph6_out(F, A); if (DBLQ(6)) ph6_out(F, A); } SEAM(6);
    if (IN(7)) { p7_ln_router(F, A); p7_expert_weights(F, A); if (DBLQ(11)) { __syncthreads(); p7_expert_weights(F, A); } } SEAM(7);
    if (IN(8)) { ph8_moe1(F, A); if (DBLQ(8)) ph8_moe1(F, A); } SEAM(8);
    if (IN(9)) { ph9_moe2(F, A); if (DBLQ(9)) ph9_moe2(F, A); } SEAM(9);
    if (IN(10)) { p10_final(F, A); }
#undef IN
#undef SEAM
}

extern "C" void kernel_launch(void* const* d_in, const int* in_sizes, int n_in, void* d_out, int out_size, void* d_ws, size_t ws_size, hipStream_t stream) {
    static int grid = 0;
    if (grid == 0) {
        if (n_in != 17 || in_sizes[0] != T * D || out_size != T * D || ws_size < WS_END) { fprintf(stderr, "kernel_launch: unexpected shapes (n_in %d, in0 %d, out %d, ws %zu < %zu); nothing launched\n", n_in, n_in > 0 ? in_sizes[0] : -1, out_size, ws_size, (size_t)WS_END); grid = -1; return; }
        int dev = 0, cus = 0, per_cu = 0;
        if (hipGetDevice(&dev) != hipSuccess || hipDeviceGetAttribute(&cus, hipDeviceAttributeMultiprocessorCount, dev) != hipSuccess) { grid = -1; return; }
        if (hipFuncSetAttribute((const void*)fwd_kernel, hipFuncAttributeMaxDynamicSharedMemorySize, LDS_BYTES) != hipSuccess) { fprintf(stderr, "kernel_launch: hipFuncSetAttribute failed\n"); grid = -1; return; }
        if (hipOccupancyMaxActiveBlocksPerMultiprocessor(&per_cu, (const void*)fwd_kernel, NWAVES * 64, LDS_BYTES) != hipSuccess || per_cu < 1)
            fprintf(stderr, "kernel_launch: note: occupancy query reports %d workgroups per CU\n", per_cu);
        (void)hipGetLastError();
        grid = cus;
    }
    if (grid < 0) return;
    if (hipMemsetAsync((char*)d_ws + WS_CTL, 0, CTL_ZERO_BYTES, stream) != hipSuccess) return;
    Args a{};
    for (int i = 0; i < 17; ++i) a.in[i] = (const float*)d_in[i];
    a.out = (float*)d_out; a.ws = (unsigned char*)d_ws;
#if MK_SPLIT
    for (int p = 0; p < N_PHASES; ++p) { a.ph_lo = p; a.ph_hi = p + 1; hipLaunchKernelGGL(fwd_kernel, dim3(grid), dim3(NWAVES * 64), LDS_BYTES, stream, a); }
#else
    a.ph_lo = 0; a.ph_hi = N_PHASES;
    hipLaunchKernelGGL(fwd_kernel, dim3(grid), dim3(NWAVES * 64), LDS_BYTES, stream, a);
#endif
    const hipError_t le = hipPeekAtLastError();
    if (le != hipSuccess) fprintf(stderr, "kernel_launch: launch failed: %s\n", hipGetErrorName(le));
}
```
